# Optimizing an MI355X kernel written in HIP

```python
import jax, jax.numpy as jnp
from jax import lax
import numpy as np

D_MODEL = 1024
BATCH = 16
SEQ = 2048
DEPTH = 1

N_META = 16
RET_HEADS = 8
RET_DK = 64
RET_DV = 128
RET_CHUNK = 128
RET_W = RET_HEADS * RET_DV
ATT_Q_HEADS = 16
ATT_KV_HEADS = 4
ATT_GROUP = ATT_Q_HEADS // ATT_KV_HEADS
ATT_DH = 64
ATT_W = ATT_Q_HEADS * ATT_DH
WINDOW = 128
ATT_BLOCK = 128
D_FF = -(-8 * D_MODEL // (3 * 256)) * 256
IN_SIZES = (RET_HEADS * RET_DK, RET_HEADS * RET_DK, RET_W, RET_W,
            ATT_Q_HEADS * ATT_DH, ATT_KV_HEADS * ATT_DH, ATT_KV_HEADS * ATT_DH,
            D_MODEL, D_MODEL)
IN_COLS = sum(IN_SIZES)
RMS_EPS = 1e-6
GN_EPS = 1e-5
NEG_INF = -1e30

kernel_name = "hybrid_retention_swa_alibi_meta_encoder"


def rmsnorm(x, g):
    x32 = x.astype(jnp.float32)
    y = x32 * lax.rsqrt(jnp.mean(x32 * x32, axis=-1, keepdims=True) + RMS_EPS)
    return (y * g.astype(jnp.float32)).astype(x.dtype)


def alibi_slopes(n_heads):
    return 2.0 ** (-8.0 * jnp.arange(1, n_heads + 1, dtype=jnp.float32) / n_heads)


def _retention_scan(q, k, v, log_gamma, strict):
    C = q.shape[3]
    idx = jnp.arange(C, dtype=jnp.float32)
    diff = idx[:, None] - idx[None, :]
    mask = (diff > 0) if strict else (diff >= 0)
    decay_intra = jnp.where(mask, jnp.exp(jnp.where(mask, diff, 0.0)[None] * log_gamma[:, None, None]), 0.0)
    q_decay = jnp.exp((idx[None, :] + 1.0) * log_gamma[:, None])[..., None]
    k_decay = jnp.exp((C - 1.0 - idx[None, :]) * log_gamma[:, None])[..., None]
    chunk_decay = jnp.exp(C * log_gamma)[:, None, None]

    def step(state, qkv):
        qc, kc, vc = qkv
        scores = jnp.einsum('bhid,bhjd->bhij', qc, kc) * decay_intra
        out = (jnp.einsum('bhij,bhje->bhie', scores, vc)
               + jnp.einsum('bhid,bhde->bhie', qc * q_decay, state))
        state = chunk_decay * state + jnp.einsum('bhjd,bhje->bhde', kc * k_decay, vc)
        return state, out

    B, H, dk, dv = q.shape[1], q.shape[2], q.shape[4], v.shape[4]
    state0 = jnp.zeros((B, H, dk, dv), jnp.float32)
    _, out = lax.scan(step, state0, (q, k, v))
    return out


def bidirectional_retention(q, k, v, g, logit_fwd, logit_bwd, gn_gain):
    B, L = q.shape[0], q.shape[1]
    pad = (-L) % RET_CHUNK
    n_chunks = (L + pad) // RET_CHUNK

    def to_chunks(t):
        t = jnp.pad(t.astype(jnp.float32), ((0, 0), (pad, 0), (0, 0), (0, 0)))
        return t.reshape(B, n_chunks, RET_CHUNK, t.shape[2], t.shape[3]).transpose(1, 0, 3, 2, 4)

    qc = to_chunks(q)
    kc = to_chunks(k) * (RET_DK ** -0.5)
    vc = to_chunks(v)
    log_gf = jax.nn.log_sigmoid(logit_fwd.astype(jnp.float32))
    log_gb = jax.nn.log_sigmoid(logit_bwd.astype(jnp.float32))
    flip = lambda t: t[::-1, :, :, ::-1]
    fwd = _retention_scan(qc, kc, vc, log_gf, False)
    bwd = flip(_retention_scan(flip(qc), flip(kc), flip(vc), log_gb, True))
    o = (fwd + bwd).transpose(1, 0, 3, 2, 4).reshape(B, n_chunks * RET_CHUNK, RET_HEADS, RET_DV)[:, pad:]
    mu = jnp.mean(o, axis=-1, keepdims=True)
    var = jnp.mean(jnp.square(o - mu), axis=-1, keepdims=True)
    o = ((o - mu) * lax.rsqrt(var + GN_EPS)).reshape(B, L, RET_W) * gn_gain.astype(jnp.float32)
    return (jax.nn.silu(g.astype(jnp.float32)) * o).astype(g.dtype)


def windowed_gqa_alibi(q, k, v, sink):
    B, L = q.shape[0], q.shape[1]
    S = L - N_META
    nb = S // ATT_BLOCK
    K, G, BLK, dh = ATT_KV_HEADS, ATT_GROUP, ATT_BLOCK, ATT_DH
    q = (q * (dh ** -0.5)).reshape(B, L, K, G, dh).transpose(0, 2, 3, 1, 4)
    k = k.transpose(0, 2, 1, 3)
    v = v.transpose(0, 2, 1, 3)
    slopes = alibi_slopes(ATT_Q_HEADS).reshape(K, G)
    sink = sink.astype(jnp.float32).reshape(K, G)
    qm, qr = q[:, :, :, :N_META], q[:, :, :, N_META:]
    km, kr = k[:, :, :N_META], k[:, :, N_META:]
    vm, vr = v[:, :, :N_META], v[:, :, N_META:]

    qb = qr.reshape(B, K, G, nb, BLK, dh)

    def band(t):
        tp = jnp.pad(t, ((0, 0), (0, 0), (BLK, BLK), (0, 0))).reshape(B, K, nb + 2, BLK, dh)
        return jnp.concatenate([tp[:, :, :-2], tp[:, :, 1:-1], tp[:, :, 2:]], axis=3)

    kb, vb = band(kr), band(vr)
    r = jnp.arange(BLK)
    j = jnp.arange(3 * BLK)
    dist = jnp.abs(j[None, :] - BLK - r[:, None])
    key_pos = jnp.arange(nb)[:, None] * BLK - BLK + j[None, :]
    valid = (dist <= WINDOW)[None] & ((key_pos >= 0) & (key_pos < S))[:, None, :]
    s_band = (jnp.einsum('bkgnqd,bknsd->bkgnqs', qb, kb).astype(jnp.float32)
              - slopes[:, :, None, None, None] * dist.astype(jnp.float32))
    s_band = jnp.where(valid, s_band, NEG_INF)
    s_meta = jnp.einsum('bkgnqd,bksd->bkgnqs', qb, km).astype(jnp.float32)
    s_sink = jnp.broadcast_to(sink[None, :, :, None, None, None], (B, K, G, nb, BLK, 1))
    p = jax.nn.softmax(jnp.concatenate([s_meta, s_band, s_sink], axis=-1), axis=-1).astype(v.dtype)
    o_real = (jnp.einsum('bkgnqs,bksd->bkgnqd', p[..., :N_META], vm)
              + jnp.einsum('bkgnqs,bknsd->bkgnqd', p[..., N_META:N_META + 3 * BLK], vb))
    o_real = o_real.reshape(B, K, G, S, dh)

    kf, vf = kr[:, :, :BLK], vr[:, :, :BLK]
    dist_m = N_META + jnp.arange(BLK)[None, :] - jnp.arange(N_META)[:, None]
    sm_meta = jnp.einsum('bkgid,bksd->bkgis', qm, km).astype(jnp.float32)
    sm_real = (jnp.einsum('bkgid,bksd->bkgis', qm, kf).astype(jnp.float32)
               - slopes[:, :, None, None] * dist_m.astype(jnp.float32))
    sm_real = jnp.where(dist_m <= WINDOW, sm_real, NEG_INF)
    sm_sink = jnp.broadcast_to(sink[None, :, :, None, None], (B, K, G, N_META, 1))
    pm = jax.nn.softmax(jnp.concatenate([sm_meta, sm_real, sm_sink], axis=-1), axis=-1).astype(v.dtype)
    o_meta = (jnp.einsum('bkgis,bksd->bkgid', pm[..., :N_META], vm)
              + jnp.einsum('bkgis,bksd->bkgid', pm[..., N_META:N_META + BLK], vf))

    o = jnp.concatenate([o_meta, o_real], axis=3)
    return o.transpose(0, 3, 1, 2, 4).reshape(B, L, ATT_W)


def hybrid_layer(x, w_in, ret_logit_f, ret_logit_b, ret_gn, attn_sink,
                 w_branch_ret, w_branch_att, w_out, norm_mix, norm_ffn, w_gate_up, w_down):
    B, L, _ = x.shape
    h = rmsnorm(x, norm_mix)
    proj = h @ w_in
    split_at = [int(c) for c in np.cumsum(IN_SIZES)[:-1]]
    rq, rk, rv, rg, aq, ak, av, ga, gb = jnp.split(proj, split_at, axis=-1)
    ret = bidirectional_retention(rq.reshape(B, L, RET_HEADS, RET_DK), rk.reshape(B, L, RET_HEADS, RET_DK),
                                  rv.reshape(B, L, RET_HEADS, RET_DV), rg, ret_logit_f, ret_logit_b, ret_gn)
    att = windowed_gqa_alibi(aq.reshape(B, L, ATT_Q_HEADS, ATT_DH), ak.reshape(B, L, ATT_KV_HEADS, ATT_DH),
                             av.reshape(B, L, ATT_KV_HEADS, ATT_DH), attn_sink)
    merged = jax.nn.sigmoid(ga) * (ret @ w_branch_ret) + jax.nn.sigmoid(gb) * (att @ w_branch_att)
    x = x + merged @ w_out
    h = rmsnorm(x, norm_ffn)
    a, b = jnp.split(h @ w_gate_up, 2, axis=-1)
    return x + (jax.nn.silu(a) * b) @ w_down


def setup_inputs(seed: int = 0) -> dict:
    key = jax.random.key(seed)
    ks = jax.random.split(key, 16)
    f32 = jnp.float32
    nrm = lambda k, shape, fan_in: jax.random.normal(k, shape, f32) * (fan_in ** -0.5)
    base = 1.0 - 2.0 ** (-5.0 - jnp.arange(RET_HEADS, dtype=f32))
    base_logit = jnp.log(base) - jnp.log1p(-base)
    return {
        "x": jax.random.normal(ks[0], (BATCH, SEQ, D_MODEL), f32),
        "meta_tokens": jax.random.normal(ks[1], (N_META, D_MODEL), f32),
        "w_in": nrm(ks[2], (DEPTH, D_MODEL, IN_COLS), D_MODEL),
        "ret_decay_logit_fwd": base_logit[None] + 0.05 * jax.random.normal(ks[3], (DEPTH, RET_HEADS), f32),
        "ret_decay_logit_bwd": base_logit[None] + 0.05 * jax.random.normal(ks[4], (DEPTH, RET_HEADS), f32),
        "ret_gn_gain": 1.0 + 0.05 * jax.random.normal(ks[5], (DEPTH, RET_W), f32),
        "attn_sink": 0.5 * jax.random.normal(ks[6], (DEPTH, ATT_Q_HEADS), f32),
        "w_branch_ret": nrm(ks[7], (DEPTH, RET_W, D_MODEL), RET_W),
        "w_branch_att": nrm(ks[8], (DEPTH, ATT_W, D_MODEL), ATT_W),
        "w_out": nrm(ks[9], (DEPTH, D_MODEL, D_MODEL), D_MODEL),
        "norm_mix": 1.0 + 0.05 * jax.random.normal(ks[10], (DEPTH, D_MODEL), f32),
        "norm_ffn": 1.0 + 0.05 * jax.random.normal(ks[11], (DEPTH, D_MODEL), f32),
        "w_gate_up": nrm(ks[12], (DEPTH, D_MODEL, 2 * D_FF), D_MODEL),
        "w_down": nrm(ks[13], (DEPTH, D_FF, D_MODEL), D_FF),
        "norm_final": 1.0 + 0.05 * jax.random.normal(ks[14], (D_MODEL,), f32),
    }


def reference(x, meta_tokens, w_in, ret_decay_logit_fwd, ret_decay_logit_bwd, ret_gn_gain, attn_sink,
              w_branch_ret, w_branch_att, w_out, norm_mix, norm_ffn, w_gate_up, w_down, norm_final):
    B = x.shape[0]
    meta = jnp.broadcast_to(meta_tokens.astype(x.dtype)[None], (B, N_META, x.shape[2]))
    h = jnp.concatenate([meta, x], axis=1)
    for layer in range(DEPTH):
        h = hybrid_layer(h, w_in[layer], ret_decay_logit_fwd[layer], ret_decay_logit_bwd[layer],
                         ret_gn_gain[layer], attn_sink[layer], w_branch_ret[layer], w_branch_att[layer],
                         w_out[layer], norm_mix[layer], norm_ffn[layer], w_gate_up[layer], w_down[layer])
    return rmsnorm(h, norm_final)[:, N_META:]
```

```cpp
#include <hip/hip_runtime.h>
#include <hip/hip_cooperative_groups.h>
#include <cstdio>
#include <cstdint>
namespace cg = cooperative_groups;
namespace pg8 {
#define PG8_LAS __attribute__((address_space(3)))
typedef unsigned short bf16_t;
typedef short bf16x8 __attribute__((ext_vector_type(8)));
typedef float f32x4 __attribute__((ext_vector_type(4)));
typedef unsigned u32x4 __attribute__((ext_vector_type(4)));
constexpr int BM = 256, BK = 64, HALF = 128, HTB = HALF * BK * 2  , STAGE_BYTES = 8 * HTB, NXCD = 8, WGM = 8;

__host__ __device__ __forceinline__ int lds_byte(int r, int c) { const int st = (r >> 4) * 2 + (c >> 5), rr = r & 15, cc = c & 31, ob = rr * 64 + cc * 2; return st * 1024 + (ob ^ (((ob >> 9) & 1) << 5)); }
__host__ __device__ __forceinline__ void stage_rc(int b, int& R, int& C) { const int st = b / 1024, sb = b % 1024, swz = sb ^ (((sb >> 9) & 1) << 5); R = (st >> 1) * 16 + swz / 64; C = (st & 1) * 32 + (swz % 64) / 2; }
__host__ __device__ __forceinline__ int perm32(int rho) { const int n = rho >> 4, i = rho & 15; return 8 * (i >> 2) + 4 * n + (i & 3); }

struct Unit { int pm, pn; };
struct Gemm { const bf16_t* A; const bf16_t* Bt; int M, N, K; };

struct StaticOrder {
    int nM, nN, nwg, G, c;
    __host__ __device__ void init(int M, int N, int G_, int c_) { nM = M / BM; nN = N / BM; nwg = nM * nN; G = G_; c = c_; }
    __host__ __device__ bool next(int i, Unit& u) const {
        const long L = (long)i * G + c; if (L >= nwg) return false;
        int wgid = (int)L; { const int q = nwg / NXCD, r = nwg % NXCD, xcd = wgid % NXCD, off = wgid / NXCD; wgid = (xcd < r ? xcd * (q + 1) : r * (q + 1) + (xcd - r) * q) + off; }
        const int nig = WGM * nN, gid = wgid / nig, fm = gid * WGM, gsz = (nM - fm) < WGM ? (nM - fm) : WGM;
        u.pm = fm + ((wgid % nig) % gsz); u.pn = (wgid % nig) / gsz; return true;
    }
    __device__ __forceinline__ void a_ready(const Unit&) const {}
    __device__ __forceinline__ void done(const Unit&) const {}
};

__device__ __forceinline__ unsigned cvt_pk_bf16(float lo, float hi) { unsigned r; asm volatile("v_cvt_pk_bf16_f32 %0, %1, %2" : "=v"(r) : "v"(lo), "v"(hi)); return r; }
typedef float f32x2 __attribute__((ext_vector_type(2)));
template <class Epi, class Sched, bool ALIGN_EPI = false, bool SP2 = false>
__device__ __forceinline__ void gemm_phase(PG8_LAS unsigned char* lds, const Gemm g, const Sched& S, const Epi& E) {
    const int tid = threadIdx.x, wid = __builtin_amdgcn_readfirstlane(tid >> 6), lane = tid & 63, wr = wid >> 2, wc = wid & 3, fr = lane & 15, fq = lane >> 4;
    const int K = g.K, nt = K / BK;
    unsigned voffA[2], voffB[2];
#pragma unroll
    for (int i = 0; i < 2; ++i) { int R, C; stage_rc(tid * 16 + i * 8192, R, C); const int Rb = Epi::PERM ? ((R & ~31) + perm32(R & 31)) : R;
        voffA[i] = (unsigned)(R * K + C) * 2u; voffB[i] = (unsigned)(Rb * K + C) * 2u; }
    const size_t kstep = (size_t)(BK * 2);
    const size_t hstep = (size_t)HALF * K * 2;
    const size_t tstep = 2 * hstep;
    const unsigned ldsw = (unsigned)wid * 1024u;
    const int aoff = lds_byte(wr * 64 + fr, fq * 8), boff = lds_byte(wc * 32 + fr, fq * 8);
#define PG8_SA(b, h) (((b) * 2 + (h)) * HTB)
#define PG8_SB(b, h) ((4 + (b) * 2 + (h)) * HTB)
#define PG8_STAGE(bufoff, gbase, voff) do { _Pragma("unroll") for (int _i = 0; _i < 2; ++_i) \
        __builtin_amdgcn_global_load_lds((const unsigned*)((const char*)(gbase) + (voff)[_i]), (PG8_LAS unsigned*)(lds + (bufoff) + ldsw + _i * 8192), 16, 0, 0); } while (0)
#define PG8_LDA(dst, b, h) do { _Pragma("unroll") for (int m = 0; m < 4; ++m) _Pragma("unroll") for (int k = 0; k < 2; ++k) dst[m][k] = *(const PG8_LAS bf16x8*)(lds + PG8_SA(b, h) + aoff + m * 2048 + k * 1024); } while (0)
#define PG8_LDB(dst, b, h) do { _Pragma("unroll") for (int n = 0; n < 2; ++n) _Pragma("unroll") for (int k = 0; k < 2; ++k) dst[n][k] = *(const PG8_LAS bf16x8*)(lds + PG8_SB(b, h) + boff + n * 2048 + k * 1024); } while (0)
#define PG8_MMA(ai, bj, At, Bt) do { __builtin_amdgcn_s_setprio(1); _Pragma("unroll") for (int m = 0; m < 4; ++m) _Pragma("unroll") for (int n = 0; n < 2; ++n) _Pragma("unroll") for (int k = 0; k < 2; ++k) \
        acc[ai][bj][m][n] = __builtin_amdgcn_mfma_f32_16x16x32_bf16(Bt[n][k], At[m][k], acc[ai][bj][m][n], 0, 0, 0); __builtin_amdgcn_s_setprio(0); } while (0)
#define PG8_WAIT_V(n) asm volatile("s_waitcnt vmcnt(" #n ")" ::: "memory")
#define PG8_WAIT_L(n) asm volatile("s_waitcnt lgkmcnt(" #n ")" ::: "memory")
#define PG8_BAR __builtin_amdgcn_s_barrier()
#define PG8_SCHED __builtin_amdgcn_sched_barrier(0)
    Unit cur, nxt; int ui = 0;
    if (!S.next(0, cur)) return;
    f32x4 acc[2][2][4][2];
#pragma unroll
    for (int a = 0; a < 2; ++a)
#pragma unroll
        for (int b = 0; b < 2; ++b)
#pragma unroll
            for (int m = 0; m < 4; ++m)
#pragma unroll
                for (int n = 0; n < 2; ++n) acc[a][b][m][n] = (f32x4){0.f, 0.f, 0.f, 0.f};
    bf16x8 At[4][2], B0[2][2], B1[2][2];
    const char* cA = (const char*)g.A + (size_t)cur.pm * tstep; const char* cB = (const char*)g.Bt + (size_t)cur.pn * tstep;
    S.a_ready(cur);
    if constexpr (SP2) {
        PG8_STAGE(PG8_SB(0, 0), cB, voffB); PG8_STAGE(PG8_SB(0, 1), cB + hstep, voffB); PG8_STAGE(PG8_SA(0, 0), cA, voffA); PG8_STAGE(PG8_SA(0, 1), cA + hstep, voffA);
        if (wr == 1) PG8_BAR;
        PG8_WAIT_V(2); PG8_BAR;
        PG8_STAGE(PG8_SB(1, 0), cB + kstep, voffB); PG8_STAGE(PG8_SA(1, 0), cA + kstep, voffA); PG8_STAGE(PG8_SB(1, 1), cB + hstep + kstep, voffB);
        PG8_WAIT_V(6); PG8_BAR;
    } else {
        PG8_STAGE(PG8_SB(0, 0), cB, voffB); PG8_STAGE(PG8_SA(0, 0), cA, voffA); PG8_STAGE(PG8_SB(0, 1), cB + hstep, voffB); PG8_STAGE(PG8_SA(0, 1), cA + hstep, voffA);
        if (wr == 1) PG8_BAR;
        PG8_WAIT_V(4); PG8_BAR;
        PG8_STAGE(PG8_SB(1, 0), cB + kstep, voffB); PG8_STAGE(PG8_SA(1, 0), cA + kstep, voffA); PG8_STAGE(PG8_SB(1, 1), cB + hstep + kstep, voffB);
        PG8_WAIT_V(6); PG8_BAR;
    }
    for (;;) {
        const bool has_next = S.next(ui + 1, nxt);
        const char* nA = has_next ? (const char*)g.A + (size_t)nxt.pm * tstep : cA; const char* nB = has_next ? (const char*)g.Bt + (size_t)nxt.pn * tstep : cB;
        for (int t = 0; t < nt; t += 2) {
            const bool last = (t == nt - 2);
            const char* a1 = cA + (size_t)(t + 1) * kstep;
            const char* a2 = last ? nA : cA + (size_t)(t + 2) * kstep; const char* b2 = last ? nB : cB + (size_t)(t + 2) * kstep;
            const char* a3 = a2 + kstep; const char* b3 = b2 + kstep;
            if (last && has_next) S.a_ready(nxt);
            if constexpr (SP2) {
            PG8_LDB(B0, 0, 0); PG8_LDB(B1, 0, 1); PG8_SCHED; PG8_LDA(At, 0, 0); PG8_STAGE(PG8_SA(1, 1), a1 + hstep, voffA);
            PG8_WAIT_V(8); PG8_WAIT_L(0); PG8_BAR; PG8_MMA(0, 0, At, B0); PG8_MMA(0, 1, At, B1); PG8_BAR; PG8_SCHED;
            PG8_LDA(At, 0, 1); PG8_STAGE(PG8_SB(0, 0), b2, voffB); PG8_STAGE(PG8_SB(0, 1), b2 + hstep, voffB); PG8_STAGE(PG8_SA(0, 0), a2, voffA);
            PG8_WAIT_V(8); PG8_WAIT_L(0); PG8_BAR; PG8_MMA(1, 0, At, B0); PG8_MMA(1, 1, At, B1); PG8_BAR; PG8_SCHED;
            PG8_LDB(B0, 1, 0); PG8_LDB(B1, 1, 1); PG8_SCHED; PG8_LDA(At, 1, 0); PG8_STAGE(PG8_SA(0, 1), a2 + hstep, voffA);
            PG8_WAIT_V(8); PG8_WAIT_L(0); PG8_BAR; PG8_MMA(0, 0, At, B0); PG8_MMA(0, 1, At, B1); PG8_BAR; PG8_SCHED;
            PG8_LDA(At, 1, 1); PG8_STAGE(PG8_SB(1, 0), b3, voffB); PG8_STAGE(PG8_SB(1, 1), b3 + hstep, voffB); PG8_STAGE(PG8_SA(1, 0), a3, voffA);
            PG8_WAIT_V(8); PG8_WAIT_L(0); PG8_BAR; PG8_MMA(1, 0, At, B0); PG8_MMA(1, 1, At, B1); PG8_BAR; PG8_SCHED;
            } else {
            PG8_LDB(B0, 0, 0); PG8_SCHED; PG8_LDA(At, 0, 0); PG8_STAGE(PG8_SA(1, 1), a1 + hstep, voffA);
            PG8_WAIT_L(8); PG8_BAR; PG8_WAIT_L(0); PG8_MMA(0, 0, At, B0); PG8_BAR; PG8_SCHED;
            PG8_LDB(B1, 0, 1); PG8_STAGE(PG8_SB(0, 0), b2, voffB);
            PG8_BAR; PG8_WAIT_L(0); PG8_MMA(0, 1, At, B1); PG8_BAR;
            PG8_LDA(At, 0, 1); PG8_STAGE(PG8_SA(0, 0), a2, voffA);
            PG8_BAR; PG8_WAIT_L(0); PG8_MMA(1, 0, At, B0); PG8_BAR; PG8_SCHED;
            PG8_STAGE(PG8_SB(0, 1), b2 + hstep, voffB);
            PG8_WAIT_V(6); PG8_BAR; PG8_MMA(1, 1, At, B1); PG8_BAR;
            PG8_LDB(B0, 1, 0); PG8_SCHED; PG8_LDA(At, 1, 0); PG8_STAGE(PG8_SA(0, 1), a2 + hstep, voffA);
            PG8_WAIT_L(8); PG8_BAR; PG8_WAIT_L(0); PG8_MMA(0, 0, At, B0); PG8_BAR; PG8_SCHED;
            PG8_LDB(B1, 1, 1); PG8_STAGE(PG8_SB(1, 0), b3, voffB);
            PG8_BAR; PG8_WAIT_L(0); PG8_MMA(0, 1, At, B1); PG8_BAR;
            PG8_LDA(At, 1, 1); PG8_STAGE(PG8_SA(1, 0), a3, voffA);
            PG8_BAR; PG8_WAIT_L(0); PG8_MMA(1, 0, At, B0); PG8_BAR; PG8_SCHED;
            PG8_STAGE(PG8_SB(1, 1), b3 + hstep, voffB);
            PG8_WAIT_V(6); PG8_BAR; PG8_MMA(1, 1, At, B1); PG8_BAR;
            }
        }
        if constexpr (ALIGN_EPI) { if (wr == 0) PG8_BAR; }
        if constexpr (!Epi::AFTER_DRAIN) { E(acc, cur, wr, wc, fr, fq); S.done(cur); }
        if (!has_next) break;
#pragma unroll
        for (int a = 0; a < 2; ++a)
#pragma unroll
            for (int b = 0; b < 2; ++b)
#pragma unroll
                for (int m = 0; m < 4; ++m)
#pragma unroll
                    for (int n = 0; n < 2; ++n) acc[a][b][m][n] = (f32x4){0.f, 0.f, 0.f, 0.f};
        cur = nxt; cA = nA; cB = nB; ++ui;
        if constexpr (ALIGN_EPI) { if (wr == 1) PG8_BAR; }
    }
    PG8_WAIT_V(0);
    if constexpr (!ALIGN_EPI) { if (wr == 0) PG8_BAR; }
    PG8_BAR;
    if constexpr (Epi::AFTER_DRAIN) { E.fused(acc, cur, wr, wc, fr, fq, lds, wid, lane); S.done(cur); }
#undef PG8_SA
#undef PG8_SB
#undef PG8_STAGE
#undef PG8_LDA
#undef PG8_LDB
#undef PG8_MMA
#undef PG8_WAIT_V
#undef PG8_WAIT_L
#undef PG8_BAR
#undef PG8_SCHED
}
}

constexpr int NWAVES = 8, NTHR = 512;
constexpr int BATCH = 16, SEQ = 2048, DM = 1024, NMETA = 16;
constexpr int M = BATCH * SEQ;
constexpr int RH = 8, RDK = 64, RDV = 128;
constexpr int AQH = 16, AKH = 4, ADH = 64;
constexpr int DFF = 2816, INC = 6656;
constexpr float RMS_EPS = 1e-6f, GN_EPS = 1e-5f;
constexpr int NPH = 8;

#define GAS __attribute__((address_space(1)))
#define LAS __attribute__((address_space(3)))
typedef unsigned short bf16;
typedef unsigned v4u __attribute__((ext_vector_type(4)));
typedef unsigned v2u __attribute__((ext_vector_type(2)));
typedef float f32x4 __attribute__((ext_vector_type(4)));
typedef short bf16x8 __attribute__((ext_vector_type(8)));

constexpr size_t MiB = 1u << 20;
constexpr size_t WS_CTL = 0, CTL_ZERO_BYTES = 64 * 1024;
constexpr size_t WS_MKR = 1 * MiB;
constexpr size_t WS_MVR = WS_MKR + 16 * 512 * 2;
constexpr size_t WS_MKA = WS_MVR + 16 * 1024 * 2;
constexpr size_t WS_MVA = WS_MKA + 16 * 256 * 2;
constexpr size_t WS_SSQ1 = 2 * MiB, WS_SSQ2 = 4 * MiB;
constexpr size_t WS_WIN = 6 * MiB, WS_WBR = 19 * MiB, WS_WO = 23 * MiB, WS_WGU = 25 * MiB, WS_WD = 36 * MiB;
constexpr size_t WS_RQ = 48 * MiB, WS_RK = 80 * MiB, WS_RV = 112 * MiB, WS_RG = 176 * MiB, WS_AQ = 240 * MiB, WS_AK = 304 * MiB, WS_AV = 320 * MiB, WS_GA = 336 * MiB, WS_GB = 400 * MiB, WS_END = 464 * MiB;
constexpr size_t WS_XB = WS_RQ;
constexpr size_t WS_ACT = WS_RV;
static_assert(WS_ACT + (size_t)M * DFF * 2 <= WS_AK, "act overlay");

__device__ __forceinline__ unsigned f2bf(float f) { unsigned u = __builtin_bit_cast(unsigned, f); return (u + 0x7fffu + ((u >> 16) & 1u)) >> 16; }
__device__ __forceinline__ unsigned pk2(float lo, float hi) { return f2bf(lo) | (f2bf(hi) << 16); }
__device__ __forceinline__ float bf2f(unsigned short h) { return __builtin_bit_cast(float, (unsigned)h << 16); }
__device__ __forceinline__ float bflo(unsigned w) { return __builtin_bit_cast(float, w << 16); }
__device__ __forceinline__ float bfhi(unsigned w) { return __builtin_bit_cast(float, w & 0xffff0000u); }
__device__ __forceinline__ float wave_sum(float v) {
#pragma unroll
    for (int o = 1; o < 64; o <<= 1) v += __shfl_xor(v, o);
    return v;
}
__device__ __forceinline__ float sigmoidf_(float x) { return 1.0f / (1.0f + __expf(-x)); }

struct Args { const float* in[15]; float* out; unsigned char* ws; int ph_lo, ph_hi; };

struct Epi1 {
    static constexpr bool PERM = true, AFTER_DRAIN = false;
    unsigned char* ws;
    __device__ __forceinline__ void operator()(const pg8::f32x4 (&acc)[2][2][4][2], const pg8::Unit& u, int wr, int wc, int fr, int fq) const {
        const int pn = u.pn; size_t off; int ldc, ct;
        if (pn < 2) { off = WS_RQ; ldc = 512; ct = pn; } else if (pn < 4) { off = WS_RK; ldc = 512; ct = pn - 2; } else if (pn < 8) { off = WS_RV; ldc = 1024; ct = pn - 4; }
        else if (pn < 12) { off = WS_RG; ldc = 1024; ct = pn - 8; } else if (pn < 16) { off = WS_AQ; ldc = 1024; ct = pn - 12; } else if (pn == 16) { off = WS_AK; ldc = 256; ct = 0; }
        else if (pn == 17) { off = WS_AV; ldc = 256; ct = 0; } else if (pn < 22) { off = WS_GA; ldc = 1024; ct = pn - 18; } else { off = WS_GB; ldc = 1024; ct = pn - 22; }
        bf16* base = (bf16*)(ws + off);
        const int row0 = u.pm * 256 + wr * 64 + fr, col0 = ct * 256 + wc * 32 + 8 * fq;
#pragma unroll
        for (int ai = 0; ai < 2; ++ai)
#pragma unroll
            for (int m = 0; m < 4; ++m) { bf16* rowp = base + (size_t)(row0 + ai * 128 + m * 16) * ldc + col0;
#pragma unroll
                for (int bj = 0; bj < 2; ++bj) { const pg8::f32x4 v0 = acc[ai][bj][m][0], v1 = acc[ai][bj][m][1]; v4u w;
                    w.x = pg8::cvt_pk_bf16(v0[0], v0[1]); w.y = pg8::cvt_pk_bf16(v0[2], v0[3]); w.z = pg8::cvt_pk_bf16(v1[0], v1[1]); w.w = pg8::cvt_pk_bf16(v1[2], v1[3]);
                    *(v4u*)(rowp + bj * 128) = w; } }
    }
};
struct Epi3 {
    static constexpr bool PERM = true, AFTER_DRAIN = false;
    const bf16* ga; bf16* gb; float* part;
    __device__ __forceinline__ void operator()(const pg8::f32x4 (&acc)[2][2][4][2], const pg8::Unit& u, int wr, int wc, int fr, int fq) const {
        const bool second = u.pm >= 128; const int pm = u.pm & 127, pn = u.pn & 3;
        const int row0 = pm * 256 + wr * 64 + fr, col0 = pn * 256 + wc * 32 + 8 * fq;
#pragma unroll
        for (int ai = 0; ai < 2; ++ai)
#pragma unroll
            for (int m = 0; m < 4; ++m) { const size_t ro = (size_t)(row0 + ai * 128 + m * 16) * 1024 + col0;
#pragma unroll
                for (int bj = 0; bj < 2; ++bj) { const size_t o = ro + bj * 128; const pg8::f32x4 a0 = acc[ai][bj][m][0], a1 = acc[ai][bj][m][1];
                    const v4u g = *(const v4u*)((second ? (const bf16*)gb : ga) + o);
                    pg8::f32x4 v0, v1;
                    v0[0] = sigmoidf_(bflo(g.x)) * a0[0]; v0[1] = sigmoidf_(bfhi(g.x)) * a0[1]; v0[2] = sigmoidf_(bflo(g.y)) * a0[2]; v0[3] = sigmoidf_(bfhi(g.y)) * a0[3];
                    v1[0] = sigmoidf_(bflo(g.z)) * a1[0]; v1[1] = sigmoidf_(bfhi(g.z)) * a1[1]; v1[2] = sigmoidf_(bflo(g.w)) * a1[2]; v1[3] = sigmoidf_(bfhi(g.w)) * a1[3];
                    if (!second) { *(pg8::f32x4*)(part + o) = v0; *(pg8::f32x4*)(part + o + 4) = v1; }
                    else { const pg8::f32x4 p0 = *(const pg8::f32x4*)(part + o), p1 = *(const pg8::f32x4*)(part + o + 4); v0 += p0; v1 += p1; v4u w;
                        w.x = pg8::cvt_pk_bf16(v0[0], v0[1]); w.y = pg8::cvt_pk_bf16(v0[2], v0[3]); w.z = pg8::cvt_pk_bf16(v1[0], v1[1]); w.w = pg8::cvt_pk_bf16(v1[2], v1[3]);
                        *(v4u*)(gb + o) = w; } } }
    }
};
struct Sched3 {
    pg8::StaticOrder S;
    __device__ bool next(int i, pg8::Unit& u) const { if (!S.next(i >> 1, u)) return false; if (i & 1) { u.pm += 128; u.pn += 4; } return true; }
    __device__ __forceinline__ void a_ready(const pg8::Unit&) const {}
    __device__ __forceinline__ void done(const pg8::Unit&) const {}
};
template <bool FIRST> struct EpiRes {
    static constexpr bool PERM = true, AFTER_DRAIN = false;
    const float* base; float* out; bf16* xb; float* ssq;
    __device__ __forceinline__ void operator()(const pg8::f32x4 (&acc)[2][2][4][2], const pg8::Unit& u, int wr, int wc, int fr, int fq) const {
        const int row0 = u.pm * 256 + wr * 64 + fr, col0 = u.pn * 256 + wc * 32 + 8 * fq;
#pragma unroll
        for (int ai = 0; ai < 2; ++ai)
#pragma unroll
            for (int m = 0; m < 4; ++m) { const int r = row0 + ai * 128 + m * 16; const size_t ro = (size_t)r * 1024 + col0; float ss = 0.f;
#pragma unroll
                for (int bj = 0; bj < 2; ++bj) { const size_t o = ro + bj * 128;
                    pg8::f32x4 v0 = *(const pg8::f32x4*)(base + o) + acc[ai][bj][m][0], v1 = *(const pg8::f32x4*)(base + o + 4) + acc[ai][bj][m][1];
                    *(pg8::f32x4*)(out + o) = v0; *(pg8::f32x4*)(out + o + 4) = v1;
                    ss += (v0[0] * v0[0] + v0[1] * v0[1]) + (v0[2] * v0[2] + v0[3] * v0[3]) + (v1[0] * v1[0] + v1[1] * v1[1]) + (v1[2] * v1[2] + v1[3] * v1[3]);
                    if (FIRST) { v4u w; w.x = pg8::cvt_pk_bf16(v0[0], v0[1]); w.y = pg8::cvt_pk_bf16(v0[2], v0[3]); w.z = pg8::cvt_pk_bf16(v1[0], v1[1]); w.w = pg8::cvt_pk_bf16(v1[2], v1[3]); *(v4u*)(xb + o) = w; } }
                ss += __shfl_xor(ss, 16); ss += __shfl_xor(ss, 32);
                if (fq == 0) ssq[(size_t)r * 16 + u.pn * 4 + wc] = ss; }
    }
};
struct Epi5 {
    static constexpr bool PERM = true, AFTER_DRAIN = false;
    bf16* act; const float* ssq;
    __device__ __forceinline__ void operator()(const pg8::f32x4 (&acc)[2][2][4][2], const pg8::Unit& u, int wr, int wc, int fr, int fq) const {
        const int row0 = u.pm * 256 + wr * 64 + fr, ch0 = u.pn * 128 + wc * 32 + 8 * fq;
#pragma unroll
        for (int ai = 0; ai < 2; ++ai)
#pragma unroll
            for (int m = 0; m < 4; ++m) { const int r = row0 + ai * 128 + m * 16;
                const pg8::f32x4* sp = (const pg8::f32x4*)(ssq + (size_t)r * 16); const pg8::f32x4 s0 = sp[0], s1 = sp[1], s2 = sp[2], s3 = sp[3];
                const float tot = ((s0[0] + s0[1]) + (s0[2] + s0[3])) + ((s1[0] + s1[1]) + (s1[2] + s1[3])) + ((s2[0] + s2[1]) + (s2[2] + s2[3])) + ((s3[0] + s3[1]) + (s3[2] + s3[3]));
                const float rstd = 1.0f / sqrtf(tot * (1.0f / 1024.0f) + RMS_EPS);
                float o[8];
#pragma unroll
                for (int n = 0; n < 2; ++n)
#pragma unroll
                    for (int j = 0; j < 4; ++j) { const float a = acc[ai][0][m][n][j] * rstd, b = acc[ai][1][m][n][j] * rstd; o[n * 4 + j] = a * sigmoidf_(a) * b; }
                v4u w; w.x = pg8::cvt_pk_bf16(o[0], o[1]); w.y = pg8::cvt_pk_bf16(o[2], o[3]); w.z = pg8::cvt_pk_bf16(o[4], o[5]); w.w = pg8::cvt_pk_bf16(o[6], o[7]);
                *(v4u*)(act + (size_t)r * DFF + ch0) = w; }
    }
};

__device__ __forceinline__ void p0_transpose_item(const float* W, int K, int N, bf16* WT, int k0, int n0, int drow0, const float* gk, LAS float* scr, int lane) {
#pragma unroll 8
    for (int i = 0; i < 32; ++i) { const int kk = 2 * i + (lane >> 5); float v = W[(size_t)(k0 + kk) * N + n0 + (lane & 31)]; if (gk) v *= gk[k0 + kk]; scr[kk * 33 + (lane & 31)] = v; }
    asm volatile("s_waitcnt lgkmcnt(0)" ::: "memory");
    const int c = lane & 7;
#pragma unroll
    for (int j = 0; j < 4; ++j) { const int n = (lane >> 3) + 8 * j; const LAS float* s = scr + (8 * c) * 33 + n;
        v4u o; o.x = pk2(s[0 * 33], s[1 * 33]); o.y = pk2(s[2 * 33], s[3 * 33]); o.z = pk2(s[4 * 33], s[5 * 33]); o.w = pk2(s[6 * 33], s[7 * 33]);
        *(v4u*)(WT + (size_t)(drow0 + n) * K + k0 + 8 * c) = o; }
    asm volatile("s_waitcnt lgkmcnt(0)" ::: "memory");
}
__device__ __forceinline__ void p0_prologue(const Args& a, LAS unsigned char* lds, int tid, int lane, int wave, int G) {
    unsigned char* ws = a.ws;
    LAS float* scr = (LAS float*)(lds + wave * 16384);
    const int gw = blockIdx.x * NWAVES + wave, NGW = G * NWAVES;
    constexpr int I_IN = 16 * 208, I_BR = 16 * 32, I_O = 16 * 32, I_GU = 16 * 176, I_D = 44 * 32;
    constexpr int NITEMS = I_IN + 2 * I_BR + I_O + I_GU + I_D;
    for (int it = gw; it < NITEMS; it += NGW) {
        int r = it;
        if (r < I_IN) { const int kb = r / 208, nb = r % 208; p0_transpose_item(a.in[2], 1024, INC, (bf16*)(ws + WS_WIN), 64 * kb, 32 * nb, 32 * nb, nullptr, scr, lane); continue; } r -= I_IN;
        if (r < I_BR) { const int kb = r / 32, nb = r % 32; p0_transpose_item(a.in[7], 1024, 1024, (bf16*)(ws + WS_WBR), 64 * kb, 32 * nb, 32 * nb, nullptr, scr, lane); continue; } r -= I_BR;
        if (r < I_BR) { const int kb = r / 32, nb = r % 32; p0_transpose_item(a.in[8], 1024, 1024, (bf16*)(ws + WS_WBR), 64 * kb, 32 * nb, 1024 + 32 * nb, nullptr, scr, lane); continue; } r -= I_BR;
        if (r < I_O) { const int kb = r / 32, nb = r % 32; p0_transpose_item(a.in[9], 1024, 1024, (bf16*)(ws + WS_WO), 64 * kb, 32 * nb, 32 * nb, nullptr, scr, lane); continue; } r -= I_O;
        if (r < I_GU) { const int kb = r / 176, nb = r % 176; const int n0 = 32 * nb, which = n0 / DFF, ch = n0 % DFF;
            p0_transpose_item(a.in[12], 1024, 2 * DFF, (bf16*)(ws + WS_WGU), 64 * kb, n0, (ch / 128) * 256 + which * 128 + (ch % 128), a.in[11], scr, lane); continue; } r -= I_GU;
        { const int kb = r / 32, nb = r % 32; p0_transpose_item(a.in[13], DFF, 1024, (bf16*)(ws + WS_WD), 64 * kb, 32 * nb, 32 * nb, nullptr, scr, lane); }
    }
    {
        const f32x4* gp = (const f32x4*)a.in[10] + lane; f32x4 g[4];
#pragma unroll
        for (int j = 0; j < 4; ++j) g[j] = gp[64 * j];
        bf16* hb = (bf16*)a.out;
        for (int m = gw; m < M; m += NGW) {
            const f32x4* xr = (const f32x4*)(a.in[0] + (size_t)m * DM) + lane; f32x4 v[4]; float s = 0.f;
#pragma unroll
            for (int j = 0; j < 4; ++j) { v[j] = xr[64 * j]; s += (v[j].x * v[j].x + v[j].y * v[j].y) + (v[j].z * v[j].z + v[j].w * v[j].w); }
            const float rstd = 1.0f / sqrtf(wave_sum(s) * (1.0f / DM) + RMS_EPS);
            v2u* o8 = (v2u*)(hb + (size_t)m * DM) + lane;
#pragma unroll
            for (int j = 0; j < 4; ++j) { v2u o; o.x = pk2(v[j].x * rstd * g[j].x, v[j].y * rstd * g[j].y); o.y = pk2(v[j].z * rstd * g[j].z, v[j].w * rstd * g[j].w); o8[64 * j] = o; }
        }
    }
    if (blockIdx.x < 4) {
        __syncthreads();
        LAS float* hm = (LAS float*)lds;
        {
            const f32x4* gp = (const f32x4*)a.in[10] + lane;
#pragma unroll
            for (int rr = 0; rr < 2; ++rr) { const int r = wave * 2 + rr; const f32x4* xr = (const f32x4*)(a.in[1] + (size_t)r * DM) + lane; f32x4 v[4]; float s = 0.f;
#pragma unroll
                for (int j = 0; j < 4; ++j) { v[j] = xr[64 * j]; s += (v[j].x * v[j].x + v[j].y * v[j].y) + (v[j].z * v[j].z + v[j].w * v[j].w); }
                const float rstd = 1.0f / sqrtf(wave_sum(s) * (1.0f / DM) + RMS_EPS);
#pragma unroll
                for (int j = 0; j < 4; ++j) { const f32x4 g = gp[64 * j]; f32x4 o; o.x = v[j].x * rstd * g.x; o.y = v[j].y * rstd * g.y; o.z = v[j].z * rstd * g.z; o.w = v[j].w * rstd * g.w;
                    *(LAS f32x4*)(hm + r * 1024 + (64 * j + lane) * 4) = o; } }
        }
        __syncthreads();
        const int cgi = blockIdx.x * NWAVES + wave; int src, dcol, ld; size_t dsto;
        if (cgi < 8) { src = 512 + 64 * cgi; dsto = WS_MKR; ld = 512; dcol = 64 * cgi; }
        else if (cgi < 24) { src = 1024 + 64 * (cgi - 8); dsto = WS_MVR; ld = 1024; dcol = 64 * (cgi - 8); }
        else if (cgi < 28) { src = 4096 + 64 * (cgi - 24); dsto = WS_MKA; ld = 256; dcol = 64 * (cgi - 24); }
        else { src = 4352 + 64 * (cgi - 28); dsto = WS_MVA; ld = 256; dcol = 64 * (cgi - 28); }
        float acc[16];
#pragma unroll
        for (int m = 0; m < 16; ++m) acc[m] = 0.f;
        const float* wp = a.in[2] + src + lane;
        for (int k = 0; k < 1024; k += 4) {
            const float w0 = wp[(size_t)k * INC], w1 = wp[(size_t)(k + 1) * INC], w2 = wp[(size_t)(k + 2) * INC], w3 = wp[(size_t)(k + 3) * INC];
#pragma unroll
            for (int m = 0; m < 16; ++m) { const f32x4 h = *(const LAS f32x4*)(hm + m * 1024 + k); acc[m] += (h.x * w0 + h.y * w1) + (h.z * w2 + h.w * w3); }
        }
        bf16* dst = (bf16*)(ws + dsto);
#pragma unroll
        for (int m = 0; m < 16; ++m) dst[m * ld + dcol + lane] = (bf16)f2bf(acc[m]);
        __syncthreads();
    }
}

__device__ __forceinline__ float log2_sigmoid(float x) { return -log1pf(__expf(-x)) * 1.4426950408889634f; }
__device__ __forceinline__ void naive_retention(const Args& a, int tid, int G) {
    unsigned char* ws = a.ws;
    const bf16* rq = (const bf16*)(ws + WS_RQ); const bf16* rk = (const bf16*)(ws + WS_RK); const bf16* rv = (const bf16*)(ws + WS_RV); bf16* rg = (bf16*)(ws + WS_RG);
    const bf16* mk = (const bf16*)(ws + WS_MKR); const bf16* mv = (const bf16*)(ws + WS_MVR);
    for (int it = blockIdx.x; it < BATCH * RH * 8; it += G) {
        const int b = it / (RH * 8), h = (it / 8) % RH, t = (it % 8) * 256 + (tid >> 1), half = tid & 1;
        const float l2f = log2_sigmoid(a.in[3][h]), l2b = log2_sigmoid(a.in[4][h]);
        const size_t row = (size_t)b * SEQ + t;
        v4u qp[8];
#pragma unroll
        for (int c = 0; c < 8; ++c) qp[c] = *(const v4u*)(rq + row * 512 + h * 64 + c * 8);
        float acc[64];
#pragma unroll
        for (int e = 0; e < 64; ++e) acc[e] = 0.f;
        for (int s = -NMETA; s < SEQ; ++s) {
            const bf16* kp = s < 0 ? mk + (size_t)(s + NMETA) * 512 + h * 64 : rk + ((size_t)b * SEQ + s) * 512 + h * 64;
            const bf16* vp = (s < 0 ? mv + (size_t)(s + NMETA) * 1024 + h * 128 : rv + ((size_t)b * SEQ + s) * 1024 + h * 128) + half * 64;
            float d = 0.f;
#pragma unroll
            for (int c = 0; c < 8; ++c) { const v4u kk = *(const v4u*)(kp + c * 8); const v4u qq = qp[c];
                d += bflo(qq.x) * bflo(kk.x) + bfhi(qq.x) * bfhi(kk.x) + bflo(qq.y) * bflo(kk.y) + bfhi(qq.y) * bfhi(kk.y) + bflo(qq.z) * bflo(kk.z) + bfhi(qq.z) * bfhi(kk.z) + bflo(qq.w) * bflo(kk.w) + bfhi(qq.w) * bfhi(kk.w); }
            const int dist = t - s;
            const float w = d * 0.125f * exp2f(dist >= 0 ? (float)dist * l2f : (float)(-dist) * l2b);
#pragma unroll
            for (int c = 0; c < 8; ++c) { const v4u vv = *(const v4u*)(vp + c * 8);
                acc[c * 8 + 0] += w * bflo(vv.x); acc[c * 8 + 1] += w * bfhi(vv.x); acc[c * 8 + 2] += w * bflo(vv.y); acc[c * 8 + 3] += w * bfhi(vv.y);
                acc[c * 8 + 4] += w * bflo(vv.z); acc[c * 8 + 5] += w * bfhi(vv.z); acc[c * 8 + 6] += w * bflo(vv.w); acc[c * 8 + 7] += w * bfhi(vv.w); }
        }
        float mu = 0.f;
#pragma unroll
        for (int e = 0; e < 64; ++e) mu += acc[e];
        mu += __shfl_xor(mu, 1); mu *= (1.0f / 128.0f); float var = 0.f;
#pragma unroll
        for (int e = 0; e < 64; ++e) { const float dd = acc[e] - mu; var += dd * dd; }
        var += __shfl_xor(var, 1);
        const float rstd = 1.0f / sqrtf(var * (1.0f / 128.0f) + GN_EPS);
        const float* gn = a.in[5] + h * 128 + half * 64;
#pragma unroll
        for (int c = 0; c < 8; ++c) { bf16* gp = rg + row * 1024 + h * 128 + half * 64 + c * 8; const v4u gg = *(const v4u*)gp; float o[8];
            const float gv[8] = {bflo(gg.x), bfhi(gg.x), bflo(gg.y), bfhi(gg.y), bflo(gg.z), bfhi(gg.z), bflo(gg.w), bfhi(gg.w)};
#pragma unroll
            for (int j = 0; j < 8; ++j) o[j] = gv[j] * sigmoidf_(gv[j]) * ((acc[c * 8 + j] - mu) * rstd * gn[c * 8 + j]);
            v4u w4; w4.x = pk2(o[0], o[1]); w4.y = pk2(o[2], o[3]); w4.z = pk2(o[4], o[5]); w4.w = pk2(o[6], o[7]); *(v4u*)gp = w4; }
    }
}
__device__ __forceinline__ void naive_attention(const Args& a, int tid, int G) {
    unsigned char* ws = a.ws;
    bf16* aq = (bf16*)(ws + WS_AQ); const bf16* ak = (const bf16*)(ws + WS_AK); const bf16* av = (const bf16*)(ws + WS_AV);
    const bf16* mk = (const bf16*)(ws + WS_MKA); const bf16* mv = (const bf16*)(ws + WS_MVA);
    for (int it = blockIdx.x; it < BATCH * AQH * 4; it += G) {
        const int b = it / (AQH * 4), qh = (it / 4) % AQH, t = (it % 4) * 512 + tid, kh = qh / 4;
        const float slope = exp2f(-0.5f * (float)(qh + 1));
        const size_t row = (size_t)b * SEQ + t;
        float q[64];
#pragma unroll
        for (int c = 0; c < 8; ++c) { const v4u qq = *(const v4u*)(aq + row * 1024 + qh * 64 + c * 8);
            q[c * 8 + 0] = bflo(qq.x) * 0.125f; q[c * 8 + 1] = bfhi(qq.x) * 0.125f; q[c * 8 + 2] = bflo(qq.y) * 0.125f; q[c * 8 + 3] = bfhi(qq.y) * 0.125f;
            q[c * 8 + 4] = bflo(qq.z) * 0.125f; q[c * 8 + 5] = bfhi(qq.z) * 0.125f; q[c * 8 + 6] = bflo(qq.w) * 0.125f; q[c * 8 + 7] = bfhi(qq.w) * 0.125f; }
        float mx = a.in[6][qh], l = 1.0f, acc[64];
#pragma unroll
        for (int e = 0; e < 64; ++e) acc[e] = 0.f;
        for (int j = -NMETA; j <= 256; ++j) {
            const int s = t - 128 + j;
            if (j >= 0 && (s < 0 || s >= SEQ)) continue;
            const bf16* kp = j < 0 ? mk + (size_t)(j + NMETA) * 256 + kh * 64 : ak + ((size_t)b * SEQ + s) * 256 + kh * 64;
            const bf16* vp = j < 0 ? mv + (size_t)(j + NMETA) * 256 + kh * 64 : av + ((size_t)b * SEQ + s) * 256 + kh * 64;
            float d = 0.f;
#pragma unroll
            for (int c = 0; c < 8; ++c) { const v4u kk = *(const v4u*)(kp + c * 8);
                d += q[c * 8 + 0] * bflo(kk.x) + q[c * 8 + 1] * bfhi(kk.x) + q[c * 8 + 2] * bflo(kk.y) + q[c * 8 + 3] * bfhi(kk.y) + q[c * 8 + 4] * bflo(kk.z) + q[c * 8 + 5] * bfhi(kk.z) + q[c * 8 + 6] * bflo(kk.w) + q[c * 8 + 7] * bfhi(kk.w); }
            if (j >= 0) { const int dist = j < 128 ? 128 - j : j - 128; d -= slope * (float)dist; }
            const float mn = fmaxf(mx, d), f = __expf(mx - mn), p = __expf(d - mn); mx = mn; l = l * f + p;
#pragma unroll
            for (int c = 0; c < 8; ++c) { const v4u vv = *(const v4u*)(vp + c * 8);
                acc[c * 8 + 0] = acc[c * 8 + 0] * f + p * bflo(vv.x); acc[c * 8 + 1] = acc[c * 8 + 1] * f + p * bfhi(vv.x); acc[c * 8 + 2] = acc[c * 8 + 2] * f + p * bflo(vv.y); acc[c * 8 + 3] = acc[c * 8 + 3] * f + p * bfhi(vv.y);
                acc[c * 8 + 4] = acc[c * 8 + 4] * f + p * bflo(vv.z); acc[c * 8 + 5] = acc[c * 8 + 5] * f + p * bfhi(vv.z); acc[c * 8 + 6] = acc[c * 8 + 6] * f + p * bflo(vv.w); acc[c * 8 + 7] = acc[c * 8 + 7] * f + p * bfhi(vv.w); }
        }
        const float il = 1.0f / l;
#pragma unroll
        for (int c = 0; c < 8; ++c) { v4u w4; w4.x = pk2(acc[c * 8 + 0] * il, acc[c * 8 + 1] * il); w4.y = pk2(acc[c * 8 + 2] * il, acc[c * 8 + 3] * il); w4.z = pk2(acc[c * 8 + 4] * il, acc[c * 8 + 5] * il); w4.w = pk2(acc[c * 8 + 6] * il, acc[c * 8 + 7] * il);
            *(v4u*)(aq + row * 1024 + qh * 64 + c * 8) = w4; }
    }
}

constexpr int LDS_BYTES = 147456;
#ifndef MK_N_LAUNCHES
#define MK_N_LAUNCHES 1
#endif
__global__ void __launch_bounds__(NTHR, 2) fwd_megakernel(Args a) {
    extern __shared__ __attribute__((aligned(16))) unsigned char lds_raw[];
    LAS unsigned char* lds = (LAS unsigned char*)lds_raw;
    const int tid = threadIdx.x, lane = tid & 63, wave = __builtin_amdgcn_readfirstlane(tid >> 6), G = gridDim.x;
    cg::grid_group grid = cg::this_grid();
    unsigned char* ws = a.ws;
    const int lo = a.ph_lo, hi = a.ph_hi;
#define IN(k) (lo <= (k) && (k) < hi)
#define SEAM(k) do { if (IN(k) && IN((k) + 1)) grid.sync(); } while (0)

    if (IN(0)) p0_prologue(a, lds, tid, lane, wave, G);
    SEAM(0);
    if (IN(1)) {
        pg8::Gemm g{(const pg8::bf16_t*)a.out, (const pg8::bf16_t*)(ws + WS_WIN), M, INC, 1024}; pg8::StaticOrder S; S.init(M, INC, G, (int)blockIdx.x);
        Epi1 E{ws};
        pg8::gemm_phase<Epi1, pg8::StaticOrder, true, true>(lds, g, S, E);
    }
    SEAM(1);
    if (IN(2)) { naive_retention(a, tid, G); naive_attention(a, tid, G); }
    SEAM(2);
    if (IN(3)) {
        pg8::Gemm g{(const pg8::bf16_t*)(ws + WS_RG), (const pg8::bf16_t*)(ws + WS_WBR), 2 * M, 2048, 1024}; Sched3 S; S.S.init(M, 1024, G, (int)blockIdx.x);
        Epi3 E{(const bf16*)(ws + WS_GA), (bf16*)(ws + WS_GB), a.out};
        pg8::gemm_phase<Epi3, Sched3, true, true>(lds, g, S, E);
    }
    SEAM(3);
    if (IN(4)) {
        pg8::Gemm g{(const pg8::bf16_t*)(ws + WS_GB), (const pg8::bf16_t*)(ws + WS_WO), M, 1024, 1024}; pg8::StaticOrder S; S.init(M, 1024, G, (int)blockIdx.x);
        EpiRes<true> E{a.in[0], a.out, (bf16*)(ws + WS_XB), (float*)(ws + WS_SSQ1)};
        pg8::gemm_phase<EpiRes<true>, pg8::StaticOrder, true, true>(lds, g, S, E);
    }
    SEAM(4);
    if (IN(5)) {
        pg8::Gemm g{(const pg8::bf16_t*)(ws + WS_XB), (const pg8::bf16_t*)(ws + WS_WGU), M, 2 * DFF, 1024}; pg8::StaticOrder S; S.init(M, 2 * DFF, G, (int)blockIdx.x);
        Epi5 E{(bf16*)(ws + WS_ACT), (const float*)(ws + WS_SSQ1)};
        pg8::gemm_phase<Epi5, pg8::StaticOrder, true, true>(lds, g, S, E);
    }
    SEAM(5);
    if (IN(6)) {
        pg8::Gemm g{(const pg8::bf16_t*)(ws + WS_ACT), (const pg8::bf16_t*)(ws + WS_WD), M, 1024, DFF}; pg8::StaticOrder S; S.init(M, 1024, G, (int)blockIdx.x);
        EpiRes<false> E{a.out, a.out, nullptr, (float*)(ws + WS_SSQ2)};
        pg8::gemm_phase<EpiRes<false>, pg8::StaticOrder, true, true>(lds, g, S, E);
    }
    SEAM(6);
    if (IN(7)) {
        const int gw = blockIdx.x * NWAVES + wave, NGW = G * NWAVES;
        const f32x4* gp = (const f32x4*)a.in[14] + lane; f32x4 g[4];
#pragma unroll
        for (int j = 0; j < 4; ++j) g[j] = gp[64 * j];
        const float* ssq = (const float*)(ws + WS_SSQ2);
        for (int m = gw; m < M; m += NGW) {
            const f32x4* sp = (const f32x4*)(ssq + (size_t)m * 16); const f32x4 s0 = sp[0], s1 = sp[1], s2 = sp[2], s3 = sp[3];
            const float tot = ((s0[0] + s0[1]) + (s0[2] + s0[3])) + ((s1[0] + s1[1]) + (s1[2] + s1[3])) + ((s2[0] + s2[1]) + (s2[2] + s2[3])) + ((s3[0] + s3[1]) + (s3[2] + s3[3]));
            const float rstd = 1.0f / sqrtf(tot * (1.0f / DM) + RMS_EPS);
            f32x4* xr = (f32x4*)(a.out + (size_t)m * DM) + lane;
#pragma unroll
            for (int j = 0; j < 4; ++j) { f32x4 v = xr[64 * j]; v.x *= rstd * g[j].x; v.y *= rstd * g[j].y; v.z *= rstd * g[j].z; v.w *= rstd * g[j].w; xr[64 * j] = v; }
        }
    }
#undef IN
#undef SEAM
}

extern "C" void kernel_launch(void* const* d_in, const int* in_sizes, int n_in, void* d_out, int out_size, void* d_ws, size_t ws_size, hipStream_t stream) {
    static int grid = 0;
    if (grid == 0) {
        if (n_in != 15 || out_size != M * DM || ws_size < WS_END) { fprintf(stderr, "kernel_launch: unexpected shapes: n_in %d out %d ws %zu\n", n_in, out_size, ws_size); grid = -1; return; }
        int dev = 0, cus = 0, per_cu = 0;
        (void)hipGetDevice(&dev); (void)hipDeviceGetAttribute(&cus, hipDeviceAttributeMultiprocessorCount, dev);
        if (hipFuncSetAttribute((const void*)fwd_megakernel, hipFuncAttributeMaxDynamicSharedMemorySize, LDS_BYTES) != hipSuccess) { fprintf(stderr, "kernel_launch: hipFuncSetAttribute failed\n"); grid = -1; return; }
        if (hipOccupancyMaxActiveBlocksPerMultiprocessor(&per_cu, (const void*)fwd_megakernel, NTHR, LDS_BYTES) != hipSuccess || per_cu < 1) { fprintf(stderr, "kernel_launch: occupancy query says %d\n", per_cu); per_cu = 1; }
        (void)hipGetLastError();
        grid = cus * 1;
        if (grid <= 0) grid = 256;
    }
    if (grid < 0) return;
    Args a{};
    for (int i = 0; i < 15; ++i) a.in[i] = (const float*)d_in[i];
    a.out = (float*)d_out; a.ws = (unsigned char*)d_ws;
#if MK_N_LAUNCHES == 1
    a.ph_lo = 0; a.ph_hi = NPH;
    void* kargs[] = {&a};
    hipError_t e = hipLaunchCooperativeKernel((const void*)fwd_megakernel, dim3(grid), dim3(NTHR), kargs, LDS_BYTES, stream);
    if (e != hipSuccess) fprintf(stderr, "cooperative launch failed: %s (grid %d)\n", hipGetErrorString(e), grid);
#else
    for (int p = 0; p < NPH; ++p) { a.ph_lo = p; a.ph_hi = p + 1; hipLaunchKernelGGL(fwd_megakernel, dim3(grid), dim3(NTHR), LDS_BYTES, stream, a); }
#endif
}
```

```cpp
#include <hip/hip_runtime.h>
#include <hip/hip_cooperative_groups.h>
#include <cstdio>
#include <cstdint>
namespace cg = cooperative_groups;
namespace pg8 {
#define PG8_LAS __attribute__((address_space(3)))
typedef unsigned short bf16_t;
typedef short bf16x8 __attribute__((ext_vector_type(8)));
typedef float f32x4 __attribute__((ext_vector_type(4)));
typedef unsigned u32x4 __attribute__((ext_vector_type(4)));
constexpr int BM = 256, BK = 64, HALF = 128, HTB = HALF * BK * 2  , STAGE_BYTES = 8 * HTB, NXCD = 8, WGM = 8;

__host__ __device__ __forceinline__ int lds_byte(int r, int c) { const int st = (r >> 4) * 2 + (c >> 5), rr = r & 15, cc = c & 31, ob = rr * 64 + cc * 2; return st * 1024 + (ob ^ (((ob >> 9) & 1) << 5)); }
__host__ __device__ __forceinline__ void stage_rc(int b, int& R, int& C) { const int st = b / 1024, sb = b % 1024, swz = sb ^ (((sb >> 9) & 1) << 5); R = (st >> 1) * 16 + swz / 64; C = (st & 1) * 32 + (swz % 64) / 2; }
__host__ __device__ __forceinline__ int perm32(int rho) { const int n = rho >> 4, i = rho & 15; return 8 * (i >> 2) + 4 * n + (i & 3); }

struct Unit { int pm, pn; };
struct Gemm { const bf16_t* A; const bf16_t* Bt; int M, N, K; };

struct StaticOrder {
    int nM, nN, nwg, G, c;
    __host__ __device__ void init(int M, int N, int G_, int c_) { nM = M / BM; nN = N / BM; nwg = nM * nN; G = G_; c = c_; }
    __host__ __device__ bool next(int i, Unit& u) const {
        const long L = (long)i * G + c; if (L >= nwg) return false;
        int wgid = (int)L; { const int q = nwg / NXCD, r = nwg % NXCD, xcd = wgid % NXCD, off = wgid / NXCD; wgid = (xcd < r ? xcd * (q + 1) : r * (q + 1) + (xcd - r) * q) + off; }
        const int nig = WGM * nN, gid = wgid / nig, fm = gid * WGM, gsz = (nM - fm) < WGM ? (nM - fm) : WGM;
        u.pm = fm + ((wgid % nig) % gsz); u.pn = (wgid % nig) / gsz; return true;
    }
    __device__ __forceinline__ void a_ready(const Unit&) const {}
    __device__ __forceinline__ void done(const Unit&) const {}
};

__device__ __forceinline__ unsigned cvt_pk_bf16(float lo, float hi) { unsigned r; asm volatile("v_cvt_pk_bf16_f32 %0, %1, %2" : "=v"(r) : "v"(lo), "v"(hi)); return r; }
typedef float f32x2 __attribute__((ext_vector_type(2)));
template <class Epi, class Sched, bool ALIGN_EPI = false, bool SP2 = false>
__device__ __forceinline__ void gemm_phase(PG8_LAS unsigned char* lds, const Gemm g, const Sched& S, const Epi& E) {
    const int tid = threadIdx.x, wid = __builtin_amdgcn_readfirstlane(tid >> 6), lane = tid & 63, wr = wid >> 2, wc = wid & 3, fr = lane & 15, fq = lane >> 4;
    const int K = g.K, nt = K / BK;
    unsigned voffA[2], voffB[2];
#pragma unroll
    for (int i = 0; i < 2; ++i) { int R, C; stage_rc(tid * 16 + i * 8192, R, C); const int Rb = Epi::PERM ? ((R & ~31) + perm32(R & 31)) : R;
        voffA[i] = (unsigned)(R * K + C) * 2u; voffB[i] = (unsigned)(Rb * K + C) * 2u; }
    const size_t kstep = (size_t)(BK * 2);
    const size_t hstep = (size_t)HALF * K * 2;
    const size_t tstep = 2 * hstep;
    const unsigned ldsw = (unsigned)wid * 1024u;
    const int aoff = lds_byte(wr * 64 + fr, fq * 8), boff = lds_byte(wc * 32 + fr, fq * 8);
#define PG8_SA(b, h) (((b) * 2 + (h)) * HTB)
#define PG8_SB(b, h) ((4 + (b) * 2 + (h)) * HTB)
#define PG8_STAGE(bufoff, gbase, voff) do { _Pragma("unroll") for (int _i = 0; _i < 2; ++_i) \
        __builtin_amdgcn_global_load_lds((const unsigned*)((const char*)(gbase) + (voff)[_i]), (PG8_LAS unsigned*)(lds + (bufoff) + ldsw + _i * 8192), 16, 0, 0); } while (0)
#define PG8_LDA(dst, b, h) do { _Pragma("unroll") for (int m = 0; m < 4; ++m) _Pragma("unroll") for (int k = 0; k < 2; ++k) dst[m][k] = *(const PG8_LAS bf16x8*)(lds + PG8_SA(b, h) + aoff + m * 2048 + k * 1024); } while (0)
#define PG8_LDB(dst, b, h) do { _Pragma("unroll") for (int n = 0; n < 2; ++n) _Pragma("unroll") for (int k = 0; k < 2; ++k) dst[n][k] = *(const PG8_LAS bf16x8*)(lds + PG8_SB(b, h) + boff + n * 2048 + k * 1024); } while (0)
#define PG8_MMA(ai, bj, At, Bt) do { __builtin_amdgcn_s_setprio(1); _Pragma("unroll") for (int m = 0; m < 4; ++m) _Pragma("unroll") for (int n = 0; n < 2; ++n) _Pragma("unroll") for (int k = 0; k < 2; ++k) \
        acc[ai][bj][m][n] = __builtin_amdgcn_mfma_f32_16x16x32_bf16(Bt[n][k], At[m][k], acc[ai][bj][m][n], 0, 0, 0); __builtin_amdgcn_s_setprio(0); } while (0)
#define PG8_WAIT_V(n) asm volatile("s_waitcnt vmcnt(" #n ")" ::: "memory")
#define PG8_WAIT_L(n) asm volatile("s_waitcnt lgkmcnt(" #n ")" ::: "memory")
#define PG8_BAR __builtin_amdgcn_s_barrier()
#define PG8_SCHED __builtin_amdgcn_sched_barrier(0)
    Unit cur, nxt; int ui = 0;
    if (!S.next(0, cur)) return;
    f32x4 acc[2][2][4][2];
#pragma unroll
    for (int a = 0; a < 2; ++a)
#pragma unroll
        for (int b = 0; b < 2; ++b)
#pragma unroll
            for (int m = 0; m < 4; ++m)
#pragma unroll
                for (int n = 0; n < 2; ++n) acc[a][b][m][n] = (f32x4){0.f, 0.f, 0.f, 0.f};
    bf16x8 At[4][2], B0[2][2], B1[2][2];
    const char* cA = (const char*)g.A + (size_t)cur.pm * tstep; const char* cB = (const char*)g.Bt + (size_t)cur.pn * tstep;
    S.a_ready(cur);
    if constexpr (SP2) {
        PG8_STAGE(PG8_SB(0, 0), cB, voffB); PG8_STAGE(PG8_SB(0, 1), cB + hstep, voffB); PG8_STAGE(PG8_SA(0, 0), cA, voffA); PG8_STAGE(PG8_SA(0, 1), cA + hstep, voffA);
        if (wr == 1) PG8_BAR;
        PG8_WAIT_V(2); PG8_BAR;
        PG8_STAGE(PG8_SB(1, 0), cB + kstep, voffB); PG8_STAGE(PG8_SA(1, 0), cA + kstep, voffA); PG8_STAGE(PG8_SB(1, 1), cB + hstep + kstep, voffB);
        PG8_WAIT_V(6); PG8_BAR;
    } else {
        PG8_STAGE(PG8_SB(0, 0), cB, voffB); PG8_STAGE(PG8_SA(0, 0), cA, voffA); PG8_STAGE(PG8_SB(0, 1), cB + hstep, voffB); PG8_STAGE(PG8_SA(0, 1), cA + hstep, voffA);
        if (wr == 1) PG8_BAR;
        PG8_WAIT_V(4); PG8_BAR;
        PG8_STAGE(PG8_SB(1, 0), cB + kstep, voffB); PG8_STAGE(PG8_SA(1, 0), cA + kstep, voffA); PG8_STAGE(PG8_SB(1, 1), cB + hstep + kstep, voffB);
        PG8_WAIT_V(6); PG8_BAR;
    }
    for (;;) {
        const bool has_next = S.next(ui + 1, nxt);
        const char* nA = has_next ? (const char*)g.A + (size_t)nxt.pm * tstep : cA; const char* nB = has_next ? (const char*)g.Bt + (size_t)nxt.pn * tstep : cB;
        for (int t = 0; t < nt; t += 2) {
            const bool last = (t == nt - 2);
            const char* a1 = cA + (size_t)(t + 1) * kstep;
            const char* a2 = last ? nA : cA + (size_t)(t + 2) * kstep; const char* b2 = last ? nB : cB + (size_t)(t + 2) * kstep;
            const char* a3 = a2 + kstep; const char* b3 = b2 + kstep;
            if (last && has_next) S.a_ready(nxt);
            if constexpr (SP2) {
            PG8_LDB(B0, 0, 0); PG8_LDB(B1, 0, 1); PG8_SCHED; PG8_LDA(At, 0, 0); PG8_STAGE(PG8_SA(1, 1), a1 + hstep, voffA);
            PG8_WAIT_V(8); PG8_WAIT_L(0); PG8_BAR; PG8_MMA(0, 0, At, B0); PG8_MMA(0, 1, At, B1); PG8_BAR; PG8_SCHED;
            PG8_LDA(At, 0, 1); PG8_STAGE(PG8_SB(0, 0), b2, voffB); PG8_STAGE(PG8_SB(0, 1), b2 + hstep, voffB); PG8_STAGE(PG8_SA(0, 0), a2, voffA);
            PG8_WAIT_V(8); PG8_WAIT_L(0); PG8_BAR; PG8_MMA(1, 0, At, B0); PG8_MMA(1, 1, At, B1); PG8_BAR; PG8_SCHED;
            PG8_LDB(B0, 1, 0); PG8_LDB(B1, 1, 1); PG8_SCHED; PG8_LDA(At, 1, 0); PG8_STAGE(PG8_SA(0, 1), a2 + hstep, voffA);
            PG8_WAIT_V(8); PG8_WAIT_L(0); PG8_BAR; PG8_MMA(0, 0, At, B0); PG8_MMA(0, 1, At, B1); PG8_BAR; PG8_SCHED;
            PG8_LDA(At, 1, 1); PG8_STAGE(PG8_SB(1, 0), b3, voffB); PG8_STAGE(PG8_SB(1, 1), b3 + hstep, voffB); PG8_STAGE(PG8_SA(1, 0), a3, voffA);
            PG8_WAIT_V(8); PG8_WAIT_L(0); PG8_BAR; PG8_MMA(1, 0, At, B0); PG8_MMA(1, 1, At, B1); PG8_BAR; PG8_SCHED;
            } else {
            PG8_LDB(B0, 0, 0); PG8_SCHED; PG8_LDA(At, 0, 0); PG8_STAGE(PG8_SA(1, 1), a1 + hstep, voffA);
            PG8_WAIT_L(8); PG8_BAR; PG8_WAIT_L(0); PG8_MMA(0, 0, At, B0); PG8_BAR; PG8_SCHED;
            PG8_LDB(B1, 0, 1); PG8_STAGE(PG8_SB(0, 0), b2, voffB);
            PG8_BAR; PG8_WAIT_L(0); PG8_MMA(0, 1, At, B1); PG8_BAR;
            PG8_LDA(At, 0, 1); PG8_STAGE(PG8_SA(0, 0), a2, voffA);
            PG8_BAR; PG8_WAIT_L(0); PG8_MMA(1, 0, At, B0); PG8_BAR; PG8_SCHED;
            PG8_STAGE(PG8_SB(0, 1), b2 + hstep, voffB);
            PG8_WAIT_V(6); PG8_BAR; PG8_MMA(1, 1, At, B1); PG8_BAR;
            PG8_LDB(B0, 1, 0); PG8_SCHED; PG8_LDA(At, 1, 0); PG8_STAGE(PG8_SA(0, 1), a2 + hstep, voffA);
            PG8_WAIT_L(8); PG8_BAR; PG8_WAIT_L(0); PG8_MMA(0, 0, At, B0); PG8_BAR; PG8_SCHED;
            PG8_LDB(B1, 1, 1); PG8_STAGE(PG8_SB(1, 0), b3, voffB);
            PG8_BAR; PG8_WAIT_L(0); PG8_MMA(0, 1, At, B1); PG8_BAR;
            PG8_LDA(At, 1, 1); PG8_STAGE(PG8_SA(1, 0), a3, voffA);
            PG8_BAR; PG8_WAIT_L(0); PG8_MMA(1, 0, At, B0); PG8_BAR; PG8_SCHED;
            PG8_STAGE(PG8_SB(1, 1), b3 + hstep, voffB);
            PG8_WAIT_V(6); PG8_BAR; PG8_MMA(1, 1, At, B1); PG8_BAR;
            }
        }
        if constexpr (ALIGN_EPI) { if (wr == 0) PG8_BAR; }
        if constexpr (!Epi::AFTER_DRAIN) { E(acc, cur, wr, wc, fr, fq); S.done(cur); }
        if (!has_next) break;
#pragma unroll
        for (int a = 0; a < 2; ++a)
#pragma unroll
            for (int b = 0; b < 2; ++b)
#pragma unroll
                for (int m = 0; m < 4; ++m)
#pragma unroll
                    for (int n = 0; n < 2; ++n) acc[a][b][m][n] = (f32x4){0.f, 0.f, 0.f, 0.f};
        cur = nxt; cA = nA; cB = nB; ++ui;
        if constexpr (ALIGN_EPI) { if (wr == 1) PG8_BAR; }
    }
    PG8_WAIT_V(0);
    if constexpr (!ALIGN_EPI) { if (wr == 0) PG8_BAR; }
    PG8_BAR;
    if constexpr (Epi::AFTER_DRAIN) { E.fused(acc, cur, wr, wc, fr, fq, lds, wid, lane); S.done(cur); }
#undef PG8_SA
#undef PG8_SB
#undef PG8_STAGE
#undef PG8_LDA
#undef PG8_LDB
#undef PG8_MMA
#undef PG8_WAIT_V
#undef PG8_WAIT_L
#undef PG8_BAR
#undef PG8_SCHED
}
}

constexpr int NWAVES = 8, NTHR = 512;
constexpr int BATCH = 16, SEQ = 2048, DM = 1024, NMETA = 16;
constexpr int M = BATCH * SEQ;
constexpr int RH = 8, RDK = 64, RDV = 128;
constexpr int AQH = 16, AKH = 4, ADH = 64;
constexpr int DFF = 2816, INC = 6656;
constexpr float RMS_EPS = 1e-6f, GN_EPS = 1e-5f;
constexpr int NPH = 8;

#define GAS __attribute__((address_space(1)))
#define LAS __attribute__((address_space(3)))
typedef unsigned short bf16;
typedef unsigned v4u __attribute__((ext_vector_type(4)));
typedef unsigned v2u __attribute__((ext_vector_type(2)));
typedef float f32x4 __attribute__((ext_vector_type(4)));
typedef short bf16x8 __attribute__((ext_vector_type(8)));

constexpr size_t MiB = 1u << 20;
constexpr size_t WS_CTL = 0, CTL_ZERO_BYTES = 64 * 1024;
constexpr size_t WS_MKR = 1 * MiB;
constexpr size_t WS_MVR = WS_MKR + 16 * 512 * 2;
constexpr size_t WS_MKA = WS_MVR + 16 * 1024 * 2;
constexpr size_t WS_MVA = WS_MKA + 16 * 256 * 2;
constexpr size_t WS_SSQ1 = 2 * MiB, WS_SSQ2 = 4 * MiB;
constexpr size_t WS_WIN = 6 * MiB, WS_WBR = 19 * MiB, WS_WO = 23 * MiB, WS_WGU = 25 * MiB, WS_WD = 36 * MiB;
constexpr size_t WS_RQ = 48 * MiB, WS_RK = 80 * MiB, WS_RV = 112 * MiB, WS_RG = 176 * MiB, WS_AQ = 240 * MiB, WS_AK = 304 * MiB, WS_AV = 320 * MiB, WS_GA = 336 * MiB, WS_GB = 400 * MiB, WS_END = 464 * MiB;
constexpr size_t WS_XB = WS_RQ;
constexpr size_t WS_ACT = WS_RV;
static_assert(WS_ACT + (size_t)M * DFF * 2 <= WS_AK, "act overlay");

__device__ __forceinline__ unsigned f2bf(float f) { unsigned u = __builtin_bit_cast(unsigned, f); return (u + 0x7fffu + ((u >> 16) & 1u)) >> 16; }
__device__ __forceinline__ unsigned pk2(float lo, float hi) { return f2bf(lo) | (f2bf(hi) << 16); }
__device__ __forceinline__ float bf2f(unsigned short h) { return __builtin_bit_cast(float, (unsigned)h << 16); }
__device__ __forceinline__ float bflo(unsigned w) { return __builtin_bit_cast(float, w << 16); }
__device__ __forceinline__ float bfhi(unsigned w) { return __builtin_bit_cast(float, w & 0xffff0000u); }
__device__ __forceinline__ float wave_sum(float v) {
#pragma unroll
    for (int o = 1; o < 64; o <<= 1) v += __shfl_xor(v, o);
    return v;
}
__device__ __forceinline__ float sigmoidf_(float x) { return 1.0f / (1.0f + __expf(-x)); }

struct Args { const float* in[15]; float* out; unsigned char* ws; int ph_lo, ph_hi; };

struct Epi1 {
    static constexpr bool PERM = true, AFTER_DRAIN = false;
    unsigned char* ws;
    __device__ __forceinline__ void operator()(const pg8::f32x4 (&acc)[2][2][4][2], const pg8::Unit& u, int wr, int wc, int fr, int fq) const {
        const int pn = u.pn; size_t off; int ldc, ct;
        if (pn < 2) { off = WS_RQ; ldc = 512; ct = pn; } else if (pn < 4) { off = WS_RK; ldc = 512; ct = pn - 2; } else if (pn < 8) { off = WS_RV; ldc = 1024; ct = pn - 4; }
        else if (pn < 12) { off = WS_RG; ldc = 1024; ct = pn - 8; } else if (pn < 16) { off = WS_AQ; ldc = 1024; ct = pn - 12; } else if (pn == 16) { off = WS_AK; ldc = 256; ct = 0; }
        else if (pn == 17) { off = WS_AV; ldc = 256; ct = 0; } else if (pn < 22) { off = WS_GA; ldc = 1024; ct = pn - 18; } else { off = WS_GB; ldc = 1024; ct = pn - 22; }
        bf16* base = (bf16*)(ws + off);
        const int row0 = u.pm * 256 + wr * 64 + fr, col0 = ct * 256 + wc * 32 + 8 * fq;
#pragma unroll
        for (int ai = 0; ai < 2; ++ai)
#pragma unroll
            for (int m = 0; m < 4; ++m) { bf16* rowp = base + (size_t)(row0 + ai * 128 + m * 16) * ldc + col0;
#pragma unroll
                for (int bj = 0; bj < 2; ++bj) { const pg8::f32x4 v0 = acc[ai][bj][m][0], v1 = acc[ai][bj][m][1]; v4u w;
                    w.x = pg8::cvt_pk_bf16(v0[0], v0[1]); w.y = pg8::cvt_pk_bf16(v0[2], v0[3]); w.z = pg8::cvt_pk_bf16(v1[0], v1[1]); w.w = pg8::cvt_pk_bf16(v1[2], v1[3]);
                    *(v4u*)(rowp + bj * 128) = w; } }
    }
};
struct Epi3 {
    static constexpr bool PERM = true, AFTER_DRAIN = false;
    const bf16* ga; bf16* gb; float* part;
    __device__ __forceinline__ void operator()(const pg8::f32x4 (&acc)[2][2][4][2], const pg8::Unit& u, int wr, int wc, int fr, int fq) const {
        const bool second = u.pm >= 128; const int pm = u.pm & 127, pn = u.pn & 3;
        const int row0 = pm * 256 + wr * 64 + fr, col0 = pn * 256 + wc * 32 + 8 * fq;
#pragma unroll
        for (int ai = 0; ai < 2; ++ai)
#pragma unroll
            for (int m = 0; m < 4; ++m) { const size_t ro = (size_t)(row0 + ai * 128 + m * 16) * 1024 + col0;
#pragma unroll
                for (int bj = 0; bj < 2; ++bj) { const size_t o = ro + bj * 128; const pg8::f32x4 a0 = acc[ai][bj][m][0], a1 = acc[ai][bj][m][1];
                    const v4u g = *(const v4u*)((second ? (const bf16*)gb : ga) + o);
                    pg8::f32x4 v0, v1;
                    v0[0] = sigmoidf_(bflo(g.x)) * a0[0]; v0[1] = sigmoidf_(bfhi(g.x)) * a0[1]; v0[2] = sigmoidf_(bflo(g.y)) * a0[2]; v0[3] = sigmoidf_(bfhi(g.y)) * a0[3];
                    v1[0] = sigmoidf_(bflo(g.z)) * a1[0]; v1[1] = sigmoidf_(bfhi(g.z)) * a1[1]; v1[2] = sigmoidf_(bflo(g.w)) * a1[2]; v1[3] = sigmoidf_(bfhi(g.w)) * a1[3];
                    if (!second) { *(pg8::f32x4*)(part + o) = v0; *(pg8::f32x4*)(part + o + 4) = v1; }
                    else { const pg8::f32x4 p0 = *(const pg8::f32x4*)(part + o), p1 = *(const pg8::f32x4*)(part + o + 4); v0 += p0; v1 += p1; v4u w;
                        w.x = pg8::cvt_pk_bf16(v0[0], v0[1]); w.y = pg8::cvt_pk_bf16(v0[2], v0[3]); w.z = pg8::cvt_pk_bf16(v1[0], v1[1]); w.w = pg8::cvt_pk_bf16(v1[2], v1[3]);
                        *(v4u*)(gb + o) = w; } } }
    }
};
struct Sched3 {
    pg8::StaticOrder S;
    __device__ bool next(int i, pg8::Unit& u) const { if (!S.next(i >> 1, u)) return false; if (i & 1) { u.pm += 128; u.pn += 4; } return true; }
    __device__ __forceinline__ void a_ready(const pg8::Unit&) const {}
    __device__ __forceinline__ void done(const pg8::Unit&) const {}
};
template <bool FIRST> struct EpiRes {
    static constexpr bool PERM = true, AFTER_DRAIN = false;
    const float* base; float* out; bf16* xb; float* ssq;
    __device__ __forceinline__ void operator()(const pg8::f32x4 (&acc)[2][2][4][2], const pg8::Unit& u, int wr, int wc, int fr, int fq) const {
        const int row0 = u.pm * 256 + wr * 64 + fr, col0 = u.pn * 256 + wc * 32 + 8 * fq;
#pragma unroll
        for (int ai = 0; ai < 2; ++ai)
#pragma unroll
            for (int m = 0; m < 4; ++m) { const int r = row0 + ai * 128 + m * 16; const size_t ro = (size_t)r * 1024 + col0; float ss = 0.f;
#pragma unroll
                for (int bj = 0; bj < 2; ++bj) { const size_t o = ro + bj * 128;
                    pg8::f32x4 v0 = *(const pg8::f32x4*)(base + o) + acc[ai][bj][m][0], v1 = *(const pg8::f32x4*)(base + o + 4) + acc[ai][bj][m][1];
                    *(pg8::f32x4*)(out + o) = v0; *(pg8::f32x4*)(out + o + 4) = v1;
                    ss += (v0[0] * v0[0] + v0[1] * v0[1]) + (v0[2] * v0[2] + v0[3] * v0[3]) + (v1[0] * v1[0] + v1[1] * v1[1]) + (v1[2] * v1[2] + v1[3] * v1[3]);
                    if (FIRST) { v4u w; w.x = pg8::cvt_pk_bf16(v0[0], v0[1]); w.y = pg8::cvt_pk_bf16(v0[2], v0[3]); w.z = pg8::cvt_pk_bf16(v1[0], v1[1]); w.w = pg8::cvt_pk_bf16(v1[2], v1[3]); *(v4u*)(xb + o) = w; } }
                ss += __shfl_xor(ss, 16); ss += __shfl_xor(ss, 32);
                if (fq == 0) ssq[(size_t)r * 16 + u.pn * 4 + wc] = ss; }
    }
};
struct Epi5 {
    static constexpr bool PERM = true, AFTER_DRAIN = false;
    bf16* act; const float* ssq;
    __device__ __forceinline__ void operator()(const pg8::f32x4 (&acc)[2][2][4][2], const pg8::Unit& u, int wr, int wc, int fr, int fq) const {
        const int row0 = u.pm * 256 + wr * 64 + fr, ch0 = u.pn * 128 + wc * 32 + 8 * fq;
#pragma unroll
        for (int ai = 0; ai < 2; ++ai)
#pragma unroll
            for (int m = 0; m < 4; ++m) { const int r = row0 + ai * 128 + m * 16;
                const pg8::f32x4* sp = (const pg8::f32x4*)(ssq + (size_t)r * 16); const pg8::f32x4 s0 = sp[0], s1 = sp[1], s2 = sp[2], s3 = sp[3];
                const float tot = ((s0[0] + s0[1]) + (s0[2] + s0[3])) + ((s1[0] + s1[1]) + (s1[2] + s1[3])) + ((s2[0] + s2[1]) + (s2[2] + s2[3])) + ((s3[0] + s3[1]) + (s3[2] + s3[3]));
                const float rstd = 1.0f / sqrtf(tot * (1.0f / 1024.0f) + RMS_EPS);
                float o[8];
#pragma unroll
                for (int n = 0; n < 2; ++n)
#pragma unroll
                    for (int j = 0; j < 4; ++j) { const float a = acc[ai][0][m][n][j] * rstd, b = acc[ai][1][m][n][j] * rstd; o[n * 4 + j] = a * sigmoidf_(a) * b; }
                v4u w; w.x = pg8::cvt_pk_bf16(o[0], o[1]); w.y = pg8::cvt_pk_bf16(o[2], o[3]); w.z = pg8::cvt_pk_bf16(o[4], o[5]); w.w = pg8::cvt_pk_bf16(o[6], o[7]);
                *(v4u*)(act + (size_t)r * DFF + ch0) = w; }
    }
};

__device__ __forceinline__ void p0_transpose_item(const float* W, int K, int N, bf16* WT, int k0, int n0, int drow0, const float* gk, LAS float* scr, int lane) {
#pragma unroll 8
    for (int i = 0; i < 32; ++i) { const int kk = 2 * i + (lane >> 5); float v = W[(size_t)(k0 + kk) * N + n0 + (lane & 31)]; if (gk) v *= gk[k0 + kk]; scr[kk * 33 + (lane & 31)] = v; }
    asm volatile("s_waitcnt lgkmcnt(0)" ::: "memory");
    const int c = lane & 7;
#pragma unroll
    for (int j = 0; j < 4; ++j) { const int n = (lane >> 3) + 8 * j; const LAS float* s = scr + (8 * c) * 33 + n;
        v4u o; o.x = pk2(s[0 * 33], s[1 * 33]); o.y = pk2(s[2 * 33], s[3 * 33]); o.z = pk2(s[4 * 33], s[5 * 33]); o.w = pk2(s[6 * 33], s[7 * 33]);
        *(v4u*)(WT + (size_t)(drow0 + n) * K + k0 + 8 * c) = o; }
    asm volatile("s_waitcnt lgkmcnt(0)" ::: "memory");
}
__device__ __forceinline__ void p0_prologue(const Args& a, LAS unsigned char* lds, int tid, int lane, int wave, int G) {
    unsigned char* ws = a.ws;
    LAS float* scr = (LAS float*)(lds + wave * 16384);
    const int gw = blockIdx.x * NWAVES + wave, NGW = G * NWAVES;
    constexpr int I_IN = 16 * 208, I_BR = 16 * 32, I_O = 16 * 32, I_GU = 16 * 176, I_D = 44 * 32;
    constexpr int NITEMS = I_IN + 2 * I_BR + I_O + I_GU + I_D;
    for (int it = gw; it < NITEMS; it += NGW) {
        int r = it;
        if (r < I_IN) { const int kb = r / 208, nb = r % 208; p0_transpose_item(a.in[2], 1024, INC, (bf16*)(ws + WS_WIN), 64 * kb, 32 * nb, 32 * nb, nullptr, scr, lane); continue; } r -= I_IN;
        if (r < I_BR) { const int kb = r / 32, nb = r % 32; p0_transpose_item(a.in[7], 1024, 1024, (bf16*)(ws + WS_WBR), 64 * kb, 32 * nb, 32 * nb, nullptr, scr, lane); continue; } r -= I_BR;
        if (r < I_BR) { const int kb = r / 32, nb = r % 32; p0_transpose_item(a.in[8], 1024, 1024, (bf16*)(ws + WS_WBR), 64 * kb, 32 * nb, 1024 + 32 * nb, nullptr, scr, lane); continue; } r -= I_BR;
        if (r < I_O) { const int kb = r / 32, nb = r % 32; p0_transpose_item(a.in[9], 1024, 1024, (bf16*)(ws + WS_WO), 64 * kb, 32 * nb, 32 * nb, nullptr, scr, lane); continue; } r -= I_O;
        if (r < I_GU) { const int kb = r / 176, nb = r % 176; const int n0 = 32 * nb, which = n0 / DFF, ch = n0 % DFF;
            p0_transpose_item(a.in[12], 1024, 2 * DFF, (bf16*)(ws + WS_WGU), 64 * kb, n0, (ch / 128) * 256 + which * 128 + (ch % 128), a.in[11], scr, lane); continue; } r -= I_GU;
        { const int kb = r / 32, nb = r % 32; p0_transpose_item(a.in[13], DFF, 1024, (bf16*)(ws + WS_WD), 64 * kb, 32 * nb, 32 * nb, nullptr, scr, lane); }
    }
    {
        const f32x4* gp = (const f32x4*)a.in[10] + lane; f32x4 g[4];
#pragma unroll
        for (int j = 0; j < 4; ++j) g[j] = gp[64 * j];
        bf16* hb = (bf16*)a.out;
        for (int m = gw; m < M; m += NGW) {
            const f32x4* xr = (const f32x4*)(a.in[0] + (size_t)m * DM) + lane; f32x4 v[4]; float s = 0.f;
#pragma unroll
            for (int j = 0; j < 4; ++j) { v[j] = xr[64 * j]; s += (v[j].x * v[j].x + v[j].y * v[j].y) + (v[j].z * v[j].z + v[j].w * v[j].w); }
            const float rstd = 1.0f / sqrtf(wave_sum(s) * (1.0f / DM) + RMS_EPS);
            v2u* o8 = (v2u*)(hb + (size_t)m * DM) + lane;
#pragma unroll
            for (int j = 0; j < 4; ++j) { v2u o; o.x = pk2(v[j].x * rstd * g[j].x, v[j].y * rstd * g[j].y); o.y = pk2(v[j].z * rstd * g[j].z, v[j].w * rstd * g[j].w); o8[64 * j] = o; }
        }
    }
    if (blockIdx.x < 4) {
        __syncthreads();
        LAS float* hm = (LAS float*)lds;
        {
            const f32x4* gp = (const f32x4*)a.in[10] + lane;
#pragma unroll
            for (int rr = 0; rr < 2; ++rr) { const int r = wave * 2 + rr; const f32x4* xr = (const f32x4*)(a.in[1] + (size_t)r * DM) + lane; f32x4 v[4]; float s = 0.f;
#pragma unroll
                for (int j = 0; j < 4; ++j) { v[j] = xr[64 * j]; s += (v[j].x * v[j].x + v[j].y * v[j].y) + (v[j].z * v[j].z + v[j].w * v[j].w); }
                const float rstd = 1.0f / sqrtf(wave_sum(s) * (1.0f / DM) + RMS_EPS);
#pragma unroll
                for (int j = 0; j < 4; ++j) { const f32x4 g = gp[64 * j]; f32x4 o; o.x = v[j].x * rstd * g.x; o.y = v[j].y * rstd * g.y; o.z = v[j].z * rstd * g.z; o.w = v[j].w * rstd * g.w;
                    *(LAS f32x4*)(hm + r * 1024 + (64 * j + lane) * 4) = o; } }
        }
        __syncthreads();
        const int cgi = blockIdx.x * NWAVES + wave; int src, dcol, ld; size_t dsto;
        if (cgi < 8) { src = 512 + 64 * cgi; dsto = WS_MKR; ld = 512; dcol = 64 * cgi; }
        else if (cgi < 24) { src = 1024 + 64 * (cgi - 8); dsto = WS_MVR; ld = 1024; dcol = 64 * (cgi - 8); }
        else if (cgi < 28) { src = 4096 + 64 * (cgi - 24); dsto = WS_MKA; ld = 256; dcol = 64 * (cgi - 24); }
        else { src = 4352 + 64 * (cgi - 28); dsto = WS_MVA; ld = 256; dcol = 64 * (cgi - 28); }
        float acc[16];
#pragma unroll
        for (int m = 0; m < 16; ++m) acc[m] = 0.f;
        const float* wp = a.in[2] + src + lane;
        for (int k = 0; k < 1024; k += 4) {
            const float w0 = wp[(size_t)k * INC], w1 = wp[(size_t)(k + 1) * INC], w2 = wp[(size_t)(k + 2) * INC], w3 = wp[(size_t)(k + 3) * INC];
#pragma unroll
            for (int m = 0; m < 16; ++m) { const f32x4 h = *(const LAS f32x4*)(hm + m * 1024 + k); acc[m] += (h.x * w0 + h.y * w1) + (h.z * w2 + h.w * w3); }
        }
        bf16* dst = (bf16*)(ws + dsto);
#pragma unroll
        for (int m = 0; m < 16; ++m) dst[m * ld + dcol + lane] = (bf16)f2bf(acc[m]);
        __syncthreads();
    }
}

__device__ __forceinline__ float log2_sigmoid(float x) { return -log1pf(__expf(-x)) * 1.4426950408889634f; }
__device__ __forceinline__ void naive_retention(const Args& a, int tid, int G) {
    unsigned char* ws = a.ws;
    const bf16* rq = (const bf16*)(ws + WS_RQ); const bf16* rk = (const bf16*)(ws + WS_RK); const bf16* rv = (const bf16*)(ws + WS_RV); bf16* rg = (bf16*)(ws + WS_RG);
    const bf16* mk = (const bf16*)(ws + WS_MKR); const bf16* mv = (const bf16*)(ws + WS_MVR);
    for (int it = blockIdx.x; it < BATCH * RH * 8; it += G) {
        const int b = it / (RH * 8), h = (it / 8) % RH, t = (it % 8) * 256 + (tid >> 1), half = tid & 1;
        const float l2f = log2_sigmoid(a.in[3][h]), l2b = log2_sigmoid(a.in[4][h]);
        const size_t row = (size_t)b * SEQ + t;
        v4u qp[8];
#pragma unroll
        for (int c = 0; c < 8; ++c) qp[c] = *(const v4u*)(rq + row * 512 + h * 64 + c * 8);
        float acc[64];
#pragma unroll
        for (int e = 0; e < 64; ++e) acc[e] = 0.f;
        for (int s = -NMETA; s < SEQ; ++s) {
            const bf16* kp = s < 0 ? mk + (size_t)(s + NMETA) * 512 + h * 64 : rk + ((size_t)b * SEQ + s) * 512 + h * 64;
            const bf16* vp = (s < 0 ? mv + (size_t)(s + NMETA) * 1024 + h * 128 : rv + ((size_t)b * SEQ + s) * 1024 + h * 128) + half * 64;
            float d = 0.f;
#pragma unroll
            for (int c = 0; c < 8; ++c) { const v4u kk = *(const v4u*)(kp + c * 8); const v4u qq = qp[c];
                d += bflo(qq.x) * bflo(kk.x) + bfhi(qq.x) * bfhi(kk.x) + bflo(qq.y) * bflo(kk.y) + bfhi(qq.y) * bfhi(kk.y) + bflo(qq.z) * bflo(kk.z) + bfhi(qq.z) * bfhi(kk.z) + bflo(qq.w) * bflo(kk.w) + bfhi(qq.w) * bfhi(kk.w); }
            const int dist = t - s;
            const float w = d * 0.125f * exp2f(dist >= 0 ? (float)dist * l2f : (float)(-dist) * l2b);
#pragma unroll
            for (int c = 0; c < 8; ++c) { const v4u vv = *(const v4u*)(vp + c * 8);
                acc[c * 8 + 0] += w * bflo(vv.x); acc[c * 8 + 1] += w * bfhi(vv.x); acc[c * 8 + 2] += w * bflo(vv.y); acc[c * 8 + 3] += w * bfhi(vv.y);
                acc[c * 8 + 4] += w * bflo(vv.z); acc[c * 8 + 5] += w * bfhi(vv.z); acc[c * 8 + 6] += w * bflo(vv.w); acc[c * 8 + 7] += w * bfhi(vv.w); }
        }
        float mu = 0.f;
#pragma unroll
        for (int e = 0; e < 64; ++e) mu += acc[e];
        mu += __shfl_xor(mu, 1); mu *= (1.0f / 128.0f); float var = 0.f;
#pragma unroll
        for (int e = 0; e < 64; ++e) { const float dd = acc[e] - mu; var += dd * dd; }
        var += __shfl_xor(var, 1);
        const float rstd = 1.0f / sqrtf(var * (1.0f / 128.0f) + GN_EPS);
        const float* gn = a.in[5] + h * 128 + half * 64;
#pragma unroll
        for (int c = 0; c < 8; ++c) { bf16* gp = rg + row * 1024 + h * 128 + half * 64 + c * 8; const v4u gg = *(const v4u*)gp; float o[8];
            const float gv[8] = {bflo(gg.x), bfhi(gg.x), bflo(gg.y), bfhi(gg.y), bflo(gg.z), bfhi(gg.z), bflo(gg.w), bfhi(gg.w)};
#pragma unroll
            for (int j = 0; j < 8; ++j) o[j] = gv[j] * sigmoidf_(gv[j]) * ((acc[c * 8 + j] - mu) * rstd * gn[c * 8 + j]);
            v4u w4; w4.x = pk2(o[0], o[1]); w4.y = pk2(o[2], o[3]); w4.z = pk2(o[4], o[5]); w4.w = pk2(o[6], o[7]); *(v4u*)gp = w4; }
    }
}
__device__ __forceinline__ void naive_attention(const Args& a, int tid, int G) {
    unsigned char* ws = a.ws;
    bf16* aq = (bf16*)(ws + WS_AQ); const bf16* ak = (const bf16*)(ws + WS_AK); const bf16* av = (const bf16*)(ws + WS_AV);
    const bf16* mk = (const bf16*)(ws + WS_MKA); const bf16* mv = (const bf16*)(ws + WS_MVA);
    for (int it = blockIdx.x; it < BATCH * AQH * 4; it += G) {
        const int b = it / (AQH * 4), qh = (it / 4) % AQH, t = (it % 4) * 512 + tid, kh = qh / 4;
        const float slope = exp2f(-0.5f * (float)(qh + 1));
        const size_t row = (size_t)b * SEQ + t;
        float q[64];
#pragma unroll
        for (int c = 0; c < 8; ++c) { const v4u qq = *(const v4u*)(aq + row * 1024 + qh * 64 + c * 8);
            q[c * 8 + 0] = bflo(qq.x) * 0.125f; q[c * 8 + 1] = bfhi(qq.x) * 0.125f; q[c * 8 + 2] = bflo(qq.y) * 0.125f; q[c * 8 + 3] = bfhi(qq.y) * 0.125f;
            q[c * 8 + 4] = bflo(qq.z) * 0.125f; q[c * 8 + 5] = bfhi(qq.z) * 0.125f; q[c * 8 + 6] = bflo(qq.w) * 0.125f; q[c * 8 + 7] = bfhi(qq.w) * 0.125f; }
        float mx = a.in[6][qh], l = 1.0f, acc[64];
#pragma unroll
        for (int e = 0; e < 64; ++e) acc[e] = 0.f;
        for (int j = -NMETA; j <= 256; ++j) {
            const int s = t - 128 + j;
            if (j >= 0 && (s < 0 || s >= SEQ)) continue;
            const bf16* kp = j < 0 ? mk + (size_t)(j + NMETA) * 256 + kh * 64 : ak + ((size_t)b * SEQ + s) * 256 + kh * 64;
            const bf16* vp = j < 0 ? mv + (size_t)(j + NMETA) * 256 + kh * 64 : av + ((size_t)b * SEQ + s) * 256 + kh * 64;
            float d = 0.f;
#pragma unroll
            for (int c = 0; c < 8; ++c) { const v4u kk = *(const v4u*)(kp + c * 8);
                d += q[c * 8 + 0] * bflo(kk.x) + q[c * 8 + 1] * bfhi(kk.x) + q[c * 8 + 2] * bflo(kk.y) + q[c * 8 + 3] * bfhi(kk.y) + q[c * 8 + 4] * bflo(kk.z) + q[c * 8 + 5] * bfhi(kk.z) + q[c * 8 + 6] * bflo(kk.w) + q[c * 8 + 7] * bfhi(kk.w); }
            if (j >= 0) { const int dist = j < 128 ? 128 - j : j - 128; d -= slope * (float)dist; }
            const float mn = fmaxf(mx, d), f = __expf(mx - mn), p = __expf(d - mn); mx = mn; l = l * f + p;
#pragma unroll
            for (int c = 0; c < 8; ++c) { const v4u vv = *(const v4u*)(vp + c * 8);
                acc[c * 8 + 0] = acc[c * 8 + 0] * f + p * bflo(vv.x); acc[c * 8 + 1] = acc[c * 8 + 1] * f + p * bfhi(vv.x); acc[c * 8 + 2] = acc[c * 8 + 2] * f + p * bflo(vv.y); acc[c * 8 + 3] = acc[c * 8 + 3] * f + p * bfhi(vv.y);
                acc[c * 8 + 4] = acc[c * 8 + 4] * f + p * bflo(vv.z); acc[c * 8 + 5] = acc[c * 8 + 5] * f + p * bfhi(vv.z); acc[c * 8 + 6] = acc[c * 8 + 6] * f + p * bflo(vv.w); acc[c * 8 + 7] = acc[c * 8 + 7] * f + p * bfhi(vv.w); }
        }
        const float il = 1.0f / l;
#pragma unroll
        for (int c = 0; c < 8; ++c) { v4u w4; w4.x = pk2(acc[c * 8 + 0] * il, acc[c * 8 + 1] * il); w4.y = pk2(acc[c * 8 + 2] * il, acc[c * 8 + 3] * il); w4.z = pk2(acc[c * 8 + 4] * il, acc[c * 8 + 5] * il); w4.w = pk2(acc[c * 8 + 6] * il, acc[c * 8 + 7] * il);
            *(v4u*)(aq + row * 1024 + qh * 64 + c * 8) = w4; }
    }
}

typedef float f32x16 __attribute__((ext_vector_type(16)));
typedef float f32x2_t __attribute__((ext_vector_type(2)));
typedef __bf16 bf16x2_t __attribute__((ext_vector_type(2)));
__device__ __forceinline__ unsigned cvtpk(float lo, float hi) { f32x2_t v = {lo, hi}; bf16x2_t b = __builtin_convertvector(v, bf16x2_t); return __builtin_bit_cast(unsigned, b); }
__device__ __forceinline__ bf16x8 pack8(const f32x16& x, int s) { v4u p; p.x = cvtpk(x[8 * s], x[8 * s + 1]); p.y = cvtpk(x[8 * s + 2], x[8 * s + 3]); p.z = cvtpk(x[8 * s + 4], x[8 * s + 5]); p.w = cvtpk(x[8 * s + 6], x[8 * s + 7]); return __builtin_bit_cast(bf16x8, p); }
__device__ __forceinline__ int crow(int reg, int h) { return (reg & 3) + 8 * (reg >> 2) + 4 * h; }
__device__ __forceinline__ int perm16(int x) { return (x & 3) | ((x & 4) << 1) | ((x & 8) >> 1); }
#define MFMA32(a, b, c) __builtin_amdgcn_mfma_f32_32x32x16_bf16((a), (b), (c), 0, 0, 0)
constexpr int AT_KROW = 144, AT_VROW = 848, AT_KIMG = 0, AT_VT = 416 * AT_KROW;
static_assert(AT_VT + 64 * AT_VROW <= 131072, "attention LDS");

__device__ __forceinline__ void attn_unit(const Args& a, LAS unsigned char* lds, int unit, int tid, int lane, int wave) {
    unsigned char* ws = a.ws;
    bf16* aq = (bf16*)(ws + WS_AQ); const bf16* ak = (const bf16*)(ws + WS_AK); const bf16* av = (const bf16*)(ws + WS_AV);
    const bf16* mk = (const bf16*)(ws + WS_MKA); const bf16* mv = (const bf16*)(ws + WS_MVA);
    const int n = unit & 15, kh = (unit >> 4) & 3, b = unit >> 6;
    const size_t rowb = (size_t)b * SEQ;
    for (int i = tid; i < 400 * 8; i += NTHR) {
        const int row = i >> 3, pc = i & 7; const bf16* src; int irow;
        if (row < 16) { src = mk + (size_t)row * 256 + kh * 64 + pc * 8; irow = row; }
        else { const int j = row - 16, t = 128 * (n - 1) + j; if (t < 0 || t >= SEQ) continue; src = ak + (rowb + t) * 256 + kh * 64 + pc * 8; irow = 32 + j; }
        *(LAS v4u*)(lds + AT_KIMG + irow * AT_KROW + pc * 16) = *(const v4u*)src;
    }
    for (int i = tid; i < 200 * 8; i += NTHR) {
        const int pr = i >> 3, pc = i & 7; const bf16* src; int pos;
        if (pr < 8) { src = mv + (size_t)(2 * pr) * 256 + kh * 64 + pc * 8; pos = perm16(2 * pr); }
        else { const int j = 2 * (pr - 8), t = 128 * (n - 1) + j; if (t < 0 || t >= SEQ) continue; src = av + (rowb + t) * 256 + kh * 64 + pc * 8; pos = 32 + (j & ~15) + perm16(j & 15); }
        const v4u v0 = *(const v4u*)src, v1 = *(const v4u*)(src + 256);
        LAS unsigned char* dst = lds + AT_VT + (pc * 8) * AT_VROW + pos * 2;
        *(LAS unsigned*)(dst + 0 * AT_VROW) = (v0.x & 0xffffu) | (v1.x << 16); *(LAS unsigned*)(dst + 1 * AT_VROW) = (v0.x >> 16) | (v1.x & 0xffff0000u);
        *(LAS unsigned*)(dst + 2 * AT_VROW) = (v0.y & 0xffffu) | (v1.y << 16); *(LAS unsigned*)(dst + 3 * AT_VROW) = (v0.y >> 16) | (v1.y & 0xffff0000u);
        *(LAS unsigned*)(dst + 4 * AT_VROW) = (v0.z & 0xffffu) | (v1.z << 16); *(LAS unsigned*)(dst + 5 * AT_VROW) = (v0.z >> 16) | (v1.z & 0xffff0000u);
        *(LAS unsigned*)(dst + 6 * AT_VROW) = (v0.w & 0xffffu) | (v1.w << 16); *(LAS unsigned*)(dst + 7 * AT_VROW) = (v0.w >> 16) | (v1.w & 0xffff0000u);
    }
    __syncthreads();
    const int r = lane & 31, h = lane >> 5;
    constexpr float L2E = 1.4426950408889634f;
#pragma unroll 1
    for (int rep = 0; rep < 2; ++rep) {
        const int tt = wave + 8 * rep, g = tt >> 2, p = tt & 3, qh = kh * 4 + g;
        const size_t qrow = rowb + 128 * n + 32 * p + r;
        bf16* qp = aq + qrow * 1024 + qh * 64;
        bf16x8 qf[4];
#pragma unroll
        for (int ds = 0; ds < 4; ++ds) qf[ds] = *(const bf16x8*)(qp + 16 * ds + 8 * h);
        const float slope2 = exp2f(-0.5f * (float)(qh + 1)) * L2E, sc = 0.125f * L2E;
        float m = a.in[6][qh] * L2E, l = h == 0 ? 1.0f : 0.0f;
        f32x16 o0, o1;
#pragma unroll
        for (int i = 0; i < 16; ++i) { o0[i] = 0.f; o1[i] = 0.f; }
#pragma unroll 1
        for (int cc = -1; cc < 9; ++cc) {
            const int cj = p + cc;
            if (cc >= 0) { const int blk = n - 1 + (cj >> 2); if (blk < 0 || blk > 15) continue; }
            const int rowbase = cc < 0 ? 0 : 32 + 32 * cj;
            f32x16 s;
#pragma unroll
            for (int i = 0; i < 16; ++i) s[i] = 0.f;
            const LAS unsigned char* kp = lds + AT_KIMG + (rowbase + r) * AT_KROW + 16 * h;
#pragma unroll
            for (int ds = 0; ds < 4; ++ds) s = MFMA32(*(const LAS bf16x8*)(kp + 32 * ds), qf[ds], s);
            float mc = -INFINITY;
            {
                const float dq0 = (float)(32 * cc + 4 * h - 128 - r), sl = cc < 0 ? 0.f : slope2, lim = (cc == 0 || cc == 8) ? 128.0f : 1e9f;
#pragma unroll
                for (int i = 0; i < 16; ++i) { const float dq = fabsf(dq0 + (float)((i & 3) + 8 * (i >> 2))); float t = s[i] * sc - sl * dq;
                    t = dq > lim ? -INFINITY : t;
                    if (i >= 8 && cc < 0) t = -INFINITY;
                    s[i] = t; mc = fmaxf(mc, t); }
            }
            mc = fmaxf(mc, __shfl_xor(mc, 32));
            const float mn = fmaxf(m, mc);
            if (__any(mn > m)) { const float al = exp2f(m - mn); l *= al;
#pragma unroll
                for (int i = 0; i < 16; ++i) { o0[i] *= al; o1[i] *= al; } }
            m = mn;
            float ls = 0.f;
#pragma unroll
            for (int i = 0; i < 16; ++i) { s[i] = exp2f(s[i] - m); ls += s[i]; }
            l += ls;
            const LAS unsigned char* vp = lds + AT_VT + r * AT_VROW + (rowbase + 8 * h) * 2;
            {
                const bf16x8 pk = pack8(s, 0);
                o0 = MFMA32(*(const LAS bf16x8*)(vp), pk, o0);
                o1 = MFMA32(*(const LAS bf16x8*)(vp + 32 * AT_VROW), pk, o1);
            }
            if (cc >= 0) {
                const bf16x8 pk = pack8(s, 1);
                o0 = MFMA32(*(const LAS bf16x8*)(vp + 32), pk, o0);
                o1 = MFMA32(*(const LAS bf16x8*)(vp + 32 * AT_VROW + 32), pk, o1);
            }
        }
        l += __shfl_xor(l, 32);
        const float il = 1.0f / l;
#pragma unroll
        for (int gq = 0; gq < 4; ++gq) {
            v2u w0, w1;
            w0.x = cvtpk(o0[4 * gq] * il, o0[4 * gq + 1] * il); w0.y = cvtpk(o0[4 * gq + 2] * il, o0[4 * gq + 3] * il);
            w1.x = cvtpk(o1[4 * gq] * il, o1[4 * gq + 1] * il); w1.y = cvtpk(o1[4 * gq + 2] * il, o1[4 * gq + 3] * il);
            *(v2u*)(qp + 8 * gq + 4 * h) = w0; *(v2u*)(qp + 32 + 8 * gq + 4 * h) = w1;
        }
    }
    __syncthreads();
}
__device__ __forceinline__ void attn_phase(const Args& a, LAS unsigned char* lds, int tid, int lane, int wave, int G) {
    for (int u = blockIdx.x; u < BATCH * AKH * 16; u += G) attn_unit(a, lds, u, tid, lane, wave);
}

constexpr size_t WS_SB = 464 * MiB;
constexpr int RT_ROWK = 144, RT_ROWT = 272;
constexpr int RT_KIMG = 0, RT_KT = RT_KIMG + 128 * RT_ROWK, RT_VT = RT_KT + 64 * RT_ROWT, RT_STF = RT_VT + 128 * RT_ROWT, RT_STB = RT_STF + 128 * RT_ROWK, RT_XCH = RT_STB + 128 * RT_ROWK, RT_END = RT_XCH + 2048;
static_assert(RT_END <= 131072, "retention LDS");

__device__ __forceinline__ void rt_put_t(LAS unsigned char* img, int j0, int c0, v4u r0, v4u r1, float s0, float s1, bool scale) {
    const int pos = (j0 & ~15) + perm16(j0 & 15);
    LAS unsigned char* dst = img + c0 * RT_ROWT + pos * 2;
    const unsigned a[4] = {r0.x, r0.y, r0.z, r0.w}, bq[4] = {r1.x, r1.y, r1.z, r1.w};
#pragma unroll
    for (int q = 0; q < 4; ++q) {
        unsigned lo, hi;
        if (scale) { lo = cvtpk(bflo(a[q]) * s0, bflo(bq[q]) * s1); hi = cvtpk(bfhi(a[q]) * s0, bfhi(bq[q]) * s1); }
        else { lo = (a[q] & 0xffffu) | (bq[q] << 16); hi = (a[q] >> 16) | (bq[q] & 0xffff0000u); }
        *(LAS unsigned*)(dst + (2 * q) * RT_ROWT) = lo; *(LAS unsigned*)(dst + (2 * q + 1) * RT_ROWT) = hi;
    }
}
__device__ __forceinline__ void rt_tile_to_img(LAS unsigned char* img, const f32x16& t, int eb, int db, int r, int h) {
#pragma unroll
    for (int i = 0; i < 16; ++i) *(LAS unsigned short*)(img + (32 * eb + crow(i, h)) * RT_ROWK + (32 * db + r) * 2) = (unsigned short)f2bf(t[i]);
}

__device__ __forceinline__ void ret_unit(const Args& a, LAS unsigned char* lds, int unit, int tid, int lane, int wave) {
    unsigned char* ws = a.ws;
    const int b = unit >> 3, hd = unit & 7;
    const size_t rowb = (size_t)b * SEQ;
    const bf16* rq = (const bf16*)(ws + WS_RQ) + hd * 64; const bf16* rk = (const bf16*)(ws + WS_RK) + hd * 64; const bf16* rv = (const bf16*)(ws + WS_RV) + hd * 128; bf16* rg = (bf16*)(ws + WS_RG) + hd * 128;
    const bf16* mk = (const bf16*)(ws + WS_MKR) + hd * 64; const bf16* mv = (const bf16*)(ws + WS_MVR) + hd * 128;
    bf16* sbg = (bf16*)(ws + WS_SB) + (size_t)unit * 16 * 8192;
    const float l2f = log2_sigmoid(a.in[3][hd]), l2b = log2_sigmoid(a.in[4][hd]);
    const float cdf = exp2f(128.0f * l2f), cdb = exp2f(128.0f * l2b);
    const int r = lane & 31, h = lane >> 5;
    const int kpr = tid >> 3, kpc = tid & 7, vpr = tid >> 3, vpc = tid & 7;
    const int kj0 = 2 * kpr;
    const float kf0 = exp2f(l2f * (float)(127 - kj0) - 3.0f), kf1 = exp2f(l2f * (float)(126 - kj0) - 3.0f);
    const float kb0 = exp2f(l2b * (float)kj0 - 3.0f), kb1 = exp2f(l2b * (float)(kj0 + 1) - 3.0f);
    const int eb_s = wave >> 1, db_s = wave & 1;
    const LAS unsigned char* vtA = lds + RT_VT + (32 * eb_s + r) * RT_ROWT + 16 * h;
    const LAS unsigned char* ktB = lds + RT_KT + (32 * db_s + r) * RT_ROWT + 16 * h;
    f32x16 tile;
#ifndef RT_SKIP_P1
#pragma unroll
    for (int i = 0; i < 16; ++i) tile[i] = 0.f;
#pragma unroll 1
    for (int c = 15; c >= 0; --c) {
        rt_tile_to_img(lds + RT_STB, tile, eb_s, db_s, r, h);
        if (c > 0) {
            const bf16* kp = rk + (rowb + 128 * c + kj0) * 512 + kpc * 8; const v4u k0 = *(const v4u*)kp, k1 = *(const v4u*)(kp + 512);
            rt_put_t(lds + RT_KT, kj0, kpc * 8, k0, k1, kb0, kb1, true);
            const bf16* vp = rv + (rowb + 128 * c + 2 * vpr) * 1024 + vpc * 8;
            const v4u v0 = *(const v4u*)vp, v1 = *(const v4u*)(vp + 1024), v2 = *(const v4u*)(vp + 64), v3 = *(const v4u*)(vp + 1024 + 64);
            rt_put_t(lds + RT_VT, 2 * vpr, vpc * 8, v0, v1, 0.f, 0.f, false); rt_put_t(lds + RT_VT, 2 * vpr, vpc * 8 + 64, v2, v3, 0.f, 0.f, false);
        }
        __syncthreads();
        {
            bf16* dst = sbg + (size_t)c * 8192;
#pragma unroll
            for (int q = 0; q < 2; ++q) { const int pcs = tid + 512 * q, row = pcs >> 3, pc = pcs & 7; *(v4u*)(dst + row * 64 + pc * 8) = *(const LAS v4u*)(lds + RT_STB + row * RT_ROWK + pc * 16); }
        }
        if (c > 0) {
#pragma unroll
            for (int i = 0; i < 16; ++i) tile[i] *= cdb;
#pragma unroll
            for (int s = 0; s < 8; ++s) tile = MFMA32(*(const LAS bf16x8*)(vtA + 32 * s), *(const LAS bf16x8*)(ktB + 32 * s), tile);
        }
        __syncthreads();
    }
#endif
#pragma unroll
    for (int i = 0; i < 16; ++i) tile[i] = 0.f;
    {
        v4u k0 = {0u, 0u, 0u, 0u}, k1 = k0, v0 = k0, v1 = k0, v2 = k0, v3 = k0;
        if (kj0 >= 112) { const bf16* kp = mk + (size_t)(kj0 - 112) * 512 + kpc * 8; k0 = *(const v4u*)kp; k1 = *(const v4u*)(kp + 512);
            const bf16* vp = mv + (size_t)(kj0 - 112) * 1024 + vpc * 8; v0 = *(const v4u*)vp; v1 = *(const v4u*)(vp + 1024); v2 = *(const v4u*)(vp + 64); v3 = *(const v4u*)(vp + 1024 + 64); }
        rt_put_t(lds + RT_KT, kj0, kpc * 8, k0, k1, kf0, kf1, true);
        rt_put_t(lds + RT_VT, 2 * vpr, vpc * 8, v0, v1, 0.f, 0.f, false); rt_put_t(lds + RT_VT, 2 * vpr, vpc * 8 + 64, v2, v3, 0.f, 0.f, false);
        __syncthreads();
#pragma unroll
        for (int s = 0; s < 8; ++s) tile = MFMA32(*(const LAS bf16x8*)(vtA + 32 * s), *(const LAS bf16x8*)(ktB + 32 * s), tile);
        __syncthreads();
    }
#ifndef RT_SKIP_P2
    const int qt = wave & 3, eh = wave >> 2;
    const float cf = exp2f(l2f * (float)(32 * qt + r + 1)), cb = exp2f(l2b * (float)(128 - 32 * qt - r));
#pragma unroll 1
    for (int c = 0; c < 16; ++c) {
        rt_tile_to_img(lds + RT_STF, tile, eb_s, db_s, r, h);
        {
            const bf16* kp = rk + (rowb + 128 * c + kj0) * 512 + kpc * 8; const v4u k0 = *(const v4u*)kp, k1 = *(const v4u*)(kp + 512);
            *(LAS v4u*)(lds + RT_KIMG + kj0 * RT_ROWK + kpc * 16) = k0; *(LAS v4u*)(lds + RT_KIMG + (kj0 + 1) * RT_ROWK + kpc * 16) = k1;
            rt_put_t(lds + RT_KT, kj0, kpc * 8, k0, k1, kf0, kf1, true);
            const bf16* vp = rv + (rowb + 128 * c + 2 * vpr) * 1024 + vpc * 8;
            const v4u v0 = *(const v4u*)vp, v1 = *(const v4u*)(vp + 1024), v2 = *(const v4u*)(vp + 64), v3 = *(const v4u*)(vp + 1024 + 64);
            rt_put_t(lds + RT_VT, 2 * vpr, vpc * 8, v0, v1, 0.f, 0.f, false); rt_put_t(lds + RT_VT, 2 * vpr, vpc * 8 + 64, v2, v3, 0.f, 0.f, false);
            const bf16* sp = sbg + (size_t)c * 8192;
#pragma unroll
            for (int q = 0; q < 2; ++q) { const int pcs = tid + 512 * q, row = pcs >> 3, pc = pcs & 7; *(LAS v4u*)(lds + RT_STB + row * RT_ROWK + pc * 16) = *(const v4u*)(sp + row * 64 + pc * 8); }
        }
        const size_t qrow = rowb + 128 * c + 32 * qt + r;
        bf16x8 qf[4];
#pragma unroll
        for (int ds = 0; ds < 4; ++ds) qf[ds] = *(const bf16x8*)(rq + qrow * 512 + 16 * ds + 8 * h);
        __syncthreads();
        bf16x8 pk[4][2];
#pragma unroll
        for (int kc = 0; kc < 4; ++kc) {
            f32x16 s;
#pragma unroll
            for (int i = 0; i < 16; ++i) s[i] = 0.f;
            const LAS unsigned char* kp = lds + RT_KIMG + (32 * kc + r) * RT_ROWK + 16 * h;
#pragma unroll
            for (int ds = 0; ds < 4; ++ds) s = MFMA32(*(const LAS bf16x8*)(kp + 32 * ds), qf[ds], s);
            float d0 = (float)(32 * qt + r - 32 * kc - 4 * h); asm volatile("" : "+v"(d0));
#pragma unroll
            for (int i = 0; i < 16; ++i) { const float df = d0 - (float)((i & 3) + 8 * (i >> 2)); s[i] *= __builtin_amdgcn_exp2f(fminf(l2f * df, -l2b * df) - 3.0f); }
            pk[kc][0] = pack8(s, 0); pk[kc][1] = pack8(s, 1);
            __builtin_amdgcn_sched_barrier(0);
        }
        f32x16 o[2];
#pragma unroll
        for (int e2 = 0; e2 < 2; ++e2) {
            const int eb = 2 * eh + e2;
            f32x16 acc, xf, xb;
#pragma unroll
            for (int i = 0; i < 16; ++i) { acc[i] = 0.f; xf[i] = 0.f; xb[i] = 0.f; }
            const LAS unsigned char* vp = lds + RT_VT + (32 * eb + r) * RT_ROWT + 16 * h;
#pragma unroll
            for (int kc = 0; kc < 4; ++kc) { acc = MFMA32(*(const LAS bf16x8*)(vp + 64 * kc), pk[kc][0], acc); acc = MFMA32(*(const LAS bf16x8*)(vp + 64 * kc + 32), pk[kc][1], acc); }
            const LAS unsigned char* fp = lds + RT_STF + (32 * eb + r) * RT_ROWK + 16 * h; const LAS unsigned char* bp = lds + RT_STB + (32 * eb + r) * RT_ROWK + 16 * h;
#pragma unroll
            for (int ds = 0; ds < 4; ++ds) { xf = MFMA32(*(const LAS bf16x8*)(fp + 32 * ds), qf[ds], xf); xb = MFMA32(*(const LAS bf16x8*)(bp + 32 * ds), qf[ds], xb); }
#pragma unroll
            for (int i = 0; i < 16; ++i) o[e2][i] = acc[i] + cf * xf[i] + cb * xb[i];
            __builtin_amdgcn_sched_barrier(0);
        }
        float s1 = 0.f, s2 = 0.f;
#pragma unroll
        for (int e2 = 0; e2 < 2; ++e2)
#pragma unroll
            for (int i = 0; i < 16; ++i) { s1 += o[e2][i]; s2 += o[e2][i] * o[e2][i]; }
        s1 += __shfl_xor(s1, 32); s2 += __shfl_xor(s2, 32);
        LAS float* xch = (LAS float*)(lds + RT_XCH);
        if (h == 0) { xch[(eh * 128 + 32 * qt + r) * 2] = s1; xch[(eh * 128 + 32 * qt + r) * 2 + 1] = s2; }
        __builtin_amdgcn_sched_barrier(0);
#pragma unroll
        for (int i = 0; i < 16; ++i) tile[i] *= cdf;
#pragma unroll
        for (int s = 0; s < 8; ++s) tile = MFMA32(*(const LAS bf16x8*)(vtA + 32 * s), *(const LAS bf16x8*)(ktB + 32 * s), tile);
        __syncthreads();
        {
            const float p1 = xch[((eh ^ 1) * 128 + 32 * qt + r) * 2], p2 = xch[((eh ^ 1) * 128 + 32 * qt + r) * 2 + 1];
            const float mu = (s1 + p1) * (1.0f / 128.0f), var = (s2 + p2) * (1.0f / 128.0f) - mu * mu, rstd = 1.0f / sqrtf(fmaxf(var, 0.f) + GN_EPS);
            bf16* gp = rg + qrow * 1024; const float* gn = a.in[5] + hd * 128;
#pragma unroll
            for (int e2 = 0; e2 < 2; ++e2)
#pragma unroll
                for (int gq = 0; gq < 4; ++gq) { const int e0 = 32 * (2 * eh + e2) + 8 * gq + 4 * h; const v2u gg = *(const v2u*)(gp + e0); const f32x4 gv = *(const f32x4*)(gn + e0);
                    const float g0 = bflo(gg.x), g1 = bfhi(gg.x), g2 = bflo(gg.y), g3 = bfhi(gg.y);
                    v2u w; w.x = cvtpk(g0 * sigmoidf_(g0) * ((o[e2][4 * gq] - mu) * rstd * gv.x), g1 * sigmoidf_(g1) * ((o[e2][4 * gq + 1] - mu) * rstd * gv.y));
                    w.y = cvtpk(g2 * sigmoidf_(g2) * ((o[e2][4 * gq + 2] - mu) * rstd * gv.z), g3 * sigmoidf_(g3) * ((o[e2][4 * gq + 3] - mu) * rstd * gv.w));
                    *(v2u*)(gp + e0) = w; }
        }
    }
#endif
    __syncthreads();
}

constexpr int LDS_BYTES = 147456;
#ifndef MK_N_LAUNCHES
#define MK_N_LAUNCHES 1
#endif
__global__ void __launch_bounds__(NTHR, 2) fwd_megakernel(Args a) {
    extern __shared__ __attribute__((aligned(16))) unsigned char lds_raw[];
    LAS unsigned char* lds = (LAS unsigned char*)lds_raw;
    const int tid = threadIdx.x, lane = tid & 63, wave = __builtin_amdgcn_readfirstlane(tid >> 6), G = gridDim.x;
    cg::grid_group grid = cg::this_grid();
    unsigned char* ws = a.ws;
    const int lo = a.ph_lo, hi = a.ph_hi;
#define IN(k) (lo <= (k) && (k) < hi)
#define SEAM(k) do { if (IN(k) && IN((k) + 1)) grid.sync(); } while (0)

    if (IN(0)) p0_prologue(a, lds, tid, lane, wave, G);
    SEAM(0);
    if (IN(1)) {
        pg8::Gemm g{(const pg8::bf16_t*)a.out, (const pg8::bf16_t*)(ws + WS_WIN), M, INC, 1024}; pg8::StaticOrder S; S.init(M, INC, G, (int)blockIdx.x);
        Epi1 E{ws};
        pg8::gemm_phase<Epi1, pg8::StaticOrder, true, true>(lds, g, S, E);
    }
    SEAM(1);
    if (IN(2)) { for (int u = blockIdx.x; u < BATCH * RH; u += G) ret_unit(a, lds, u, tid, lane, wave); attn_phase(a, lds, tid, lane, wave, G); }
    SEAM(2);
    if (IN(3)) {
        pg8::Gemm g{(const pg8::bf16_t*)(ws + WS_RG), (const pg8::bf16_t*)(ws + WS_WBR), 2 * M, 2048, 1024}; Sched3 S; S.S.init(M, 1024, G, (int)blockIdx.x);
        Epi3 E{(const bf16*)(ws + WS_GA), (bf16*)(ws + WS_GB), a.out};
        pg8::gemm_phase<Epi3, Sched3, true, true>(lds, g, S, E);
    }
    SEAM(3);
    if (IN(4)) {
        pg8::Gemm g{(const pg8::bf16_t*)(ws + WS_GB), (const pg8::bf16_t*)(ws + WS_WO), M, 1024, 1024}; pg8::StaticOrder S; S.init(M, 1024, G, (int)blockIdx.x);
        EpiRes<true> E{a.in[0], a.out, (bf16*)(ws + WS_XB), (float*)(ws + WS_SSQ1)};
        pg8::gemm_phase<EpiRes<true>, pg8::StaticOrder, true, true>(lds, g, S, E);
    }
    SEAM(4);
    if (IN(5)) {
        pg8::Gemm g{(const pg8::bf16_t*)(ws + WS_XB), (const pg8::bf16_t*)(ws + WS_WGU), M, 2 * DFF, 1024}; pg8::StaticOrder S; S.init(M, 2 * DFF, G, (int)blockIdx.x);
        Epi5 E{(bf16*)(ws + WS_ACT), (const float*)(ws + WS_SSQ1)};
        pg8::gemm_phase<Epi5, pg8::StaticOrder, true, true>(lds, g, S, E);
    }
    SEAM(5);
    if (IN(6)) {
        pg8::Gemm g{(const pg8::bf16_t*)(ws + WS_ACT), (const pg8::bf16_t*)(ws + WS_WD), M, 1024, DFF}; pg8::StaticOrder S; S.init(M, 1024, G, (int)blockIdx.x);
        EpiRes<false> E{a.out, a.out, nullptr, (float*)(ws + WS_SSQ2)};
        pg8::gemm_phase<EpiRes<false>, pg8::StaticOrder, true, true>(lds, g, S, E);
    }
    SEAM(6);
    if (IN(7)) {
        const int gw = blockIdx.x * NWAVES + wave, NGW = G * NWAVES;
        const f32x4* gp = (const f32x4*)a.in[14] + lane; f32x4 g[4];
#pragma unroll
        for (int j = 0; j < 4; ++j) g[j] = gp[64 * j];
        const float* ssq = (const float*)(ws + WS_SSQ2);
        for (int m = gw; m < M; m += NGW) {
            const f32x4* sp = (const f32x4*)(ssq + (size_t)m * 16); const f32x4 s0 = sp[0], s1 = sp[1], s2 = sp[2], s3 = sp[3];
            const float tot = ((s0[0] + s0[1]) + (s0[2] + s0[3])) + ((s1[0] + s1[1]) + (s1[2] + s1[3])) + ((s2[0] + s2[1]) + (s2[2] + s2[3])) + ((s3[0] + s3[1]) + (s3[2] + s3[3]));
            const float rstd = 1.0f / sqrtf(tot * (1.0f / DM) + RMS_EPS);
            f32x4* xr = (f32x4*)(a.out + (size_t)m * DM) + lane;
#pragma unroll
            for (int j = 0; j < 4; ++j) { f32x4 v = xr[64 * j]; v.x *= rstd * g[j].x; v.y *= rstd * g[j].y; v.z *= rstd * g[j].z; v.w *= rstd * g[j].w; xr[64 * j] = v; }
        }
    }
#undef IN
#undef SEAM
}

extern "C" void kernel_launch(void* const* d_in, const int* in_sizes, int n_in, void* d_out, int out_size, void* d_ws, size_t ws_size, hipStream_t stream) {
    static int grid = 0;
    if (grid == 0) {
        if (n_in != 15 || out_size != M * DM || ws_size < (size_t)496 * MiB) { fprintf(stderr, "kernel_launch: unexpected shapes: n_in %d out %d ws %zu\n", n_in, out_size, ws_size); grid = -1; return; }
        int dev = 0, cus = 0, per_cu = 0;
        (void)hipGetDevice(&dev); (void)hipDeviceGetAttribute(&cus, hipDeviceAttributeMultiprocessorCount, dev);
        if (hipFuncSetAttribute((const void*)fwd_megakernel, hipFuncAttributeMaxDynamicSharedMemorySize, LDS_BYTES) != hipSuccess) { fprintf(stderr, "kernel_launch: hipFuncSetAttribute failed\n"); grid = -1; return; }
        if (hipOccupancyMaxActiveBlocksPerMultiprocessor(&per_cu, (const void*)fwd_megakernel, NTHR, LDS_BYTES) != hipSuccess || per_cu < 1) { fprintf(stderr, "kernel_launch: occupancy query says %d\n", per_cu); per_cu = 1; }
        (void)hipGetLastError();
        grid = cus * 1;
        if (grid <= 0) grid = 256;
    }
    if (grid < 0) return;
    Args a{};
    for (int i = 0; i < 15; ++i) a.in[i] = (const float*)d_in[i];
    a.out = (float*)d_out; a.ws = (unsigned char*)d_ws;
#if MK_N_LAUNCHES == 1
    a.ph_lo = 0; a.ph_hi = NPH;
    void* kargs[] = {&a};
    hipError_t e = hipLaunchCooperativeKernel((const void*)fwd_megakernel, dim3(grid), dim3(NTHR), kargs, LDS_BYTES, stream);
    if (e != hipSuccess) fprintf(stderr, "cooperative launch failed: %s (grid %d)\n", hipGetErrorString(e), grid);
#else
    for (int p = 0; p < NPH; ++p) { a.ph_lo = p; a.ph_hi = p + 1; hipLaunchKernelGGL(fwd_megakernel, dim3(grid), dim3(NTHR), LDS_BYTES, stream, a); }
#endif
}
```

```cpp
#include <hip/hip_runtime.h>
#include <hip/hip_cooperative_groups.h>
#include <cstdio>
#include <cstdint>
namespace cg = cooperative_groups;
namespace pg8 {
#define PG8_LAS __attribute__((address_space(3)))
typedef unsigned short bf16_t;
typedef short bf16x8 __attribute__((ext_vector_type(8)));
typedef float f32x4 __attribute__((ext_vector_type(4)));
typedef unsigned u32x4 __attribute__((ext_vector_type(4)));
constexpr int BM = 256, BK = 64, HALF = 128, HTB = HALF * BK * 2  , STAGE_BYTES = 8 * HTB, NXCD = 8, WGM = 8;

__host__ __device__ __forceinline__ int lds_byte(int r, int c) { const int st = (r >> 4) * 2 + (c >> 5), rr = r & 15, cc = c & 31, ob = rr * 64 + cc * 2; return st * 1024 + (ob ^ (((ob >> 9) & 1) << 5)); }
__host__ __device__ __forceinline__ void stage_rc(int b, int& R, int& C) { const int st = b / 1024, sb = b % 1024, swz = sb ^ (((sb >> 9) & 1) << 5); R = (st >> 1) * 16 + swz / 64; C = (st & 1) * 32 + (swz % 64) / 2; }
__host__ __device__ __forceinline__ int perm32(int rho) { const int n = rho >> 4, i = rho & 15; return 8 * (i >> 2) + 4 * n + (i & 3); }

struct Unit { int pm, pn; };
struct Gemm { const bf16_t* A; const bf16_t* Bt; int M, N, K; };

struct StaticOrder {
    int nM, nN, nwg, G, c;
    __host__ __device__ void init(int M, int N, int G_, int c_) { nM = M / BM; nN = N / BM; nwg = nM * nN; G = G_; c = c_; }
    __host__ __device__ bool next(int i, Unit& u) const {
        const long L = (long)i * G + c; if (L >= nwg) return false;
        int wgid = (int)L; { const int q = nwg / NXCD, r = nwg % NXCD, xcd = wgid % NXCD, off = wgid / NXCD; wgid = (xcd < r ? xcd * (q + 1) : r * (q + 1) + (xcd - r) * q) + off; }
        const int nig = WGM * nN, gid = wgid / nig, fm = gid * WGM, gsz = (nM - fm) < WGM ? (nM - fm) : WGM;
        u.pm = fm + ((wgid % nig) % gsz); u.pn = (wgid % nig) / gsz; return true;
    }
    __device__ __forceinline__ void a_ready(const Unit&) const {}
    __device__ __forceinline__ void done(const Unit&) const {}
};

__device__ __forceinline__ unsigned cvt_pk_bf16(float lo, float hi) { unsigned r; asm volatile("v_cvt_pk_bf16_f32 %0, %1, %2" : "=v"(r) : "v"(lo), "v"(hi)); return r; }
typedef float f32x2 __attribute__((ext_vector_type(2)));
template <class Epi, class Sched, bool ALIGN_EPI = false, bool SP2 = false>
__device__ __forceinline__ void gemm_phase(PG8_LAS unsigned char* lds, const Gemm g, const Sched& S, const Epi& E) {
    const int tid = threadIdx.x, wid = __builtin_amdgcn_readfirstlane(tid >> 6), lane = tid & 63, wr = wid >> 2, wc = wid & 3, fr = lane & 15, fq = lane >> 4;
    const int K = g.K, nt = K / BK;
    unsigned voffA[2], voffB[2];
#pragma unroll
    for (int i = 0; i < 2; ++i) { int R, C; stage_rc(tid * 16 + i * 8192, R, C); const int Rb = Epi::PERM ? ((R & ~31) + perm32(R & 31)) : R;
        voffA[i] = (unsigned)(R * K + C) * 2u; voffB[i] = (unsigned)(Rb * K + C) * 2u; }
    const size_t kstep = (size_t)(BK * 2);
    const size_t hstep = (size_t)HALF * K * 2;
    const size_t tstep = 2 * hstep;
    const unsigned ldsw = (unsigned)wid * 1024u;
    const int aoff = lds_byte(wr * 64 + fr, fq * 8), boff = lds_byte(wc * 32 + fr, fq * 8);
#define PG8_SA(b, h) (((b) * 2 + (h)) * HTB)
#define PG8_SB(b, h) ((4 + (b) * 2 + (h)) * HTB)
#define PG8_STAGE(bufoff, gbase, voff) do { _Pragma("unroll") for (int _i = 0; _i < 2; ++_i) \
        __builtin_amdgcn_global_load_lds((const unsigned*)((const char*)(gbase) + (voff)[_i]), (PG8_LAS unsigned*)(lds + (bufoff) + ldsw + _i * 8192), 16, 0, 0); } while (0)
#define PG8_LDA(dst, b, h) do { _Pragma("unroll") for (int m = 0; m < 4; ++m) _Pragma("unroll") for (int k = 0; k < 2; ++k) dst[m][k] = *(const PG8_LAS bf16x8*)(lds + PG8_SA(b, h) + aoff + m * 2048 + k * 1024); } while (0)
#define PG8_LDB(dst, b, h) do { _Pragma("unroll") for (int n = 0; n < 2; ++n) _Pragma("unroll") for (int k = 0; k < 2; ++k) dst[n][k] = *(const PG8_LAS bf16x8*)(lds + PG8_SB(b, h) + boff + n * 2048 + k * 1024); } while (0)
#define PG8_MMA(ai, bj, At, Bt) do { __builtin_amdgcn_s_setprio(1); _Pragma("unroll") for (int m = 0; m < 4; ++m) _Pragma("unroll") for (int n = 0; n < 2; ++n) _Pragma("unroll") for (int k = 0; k < 2; ++k) \
        acc[ai][bj][m][n] = __builtin_amdgcn_mfma_f32_16x16x32_bf16(Bt[n][k], At[m][k], acc[ai][bj][m][n], 0, 0, 0); __builtin_amdgcn_s_setprio(0); } while (0)
#define PG8_WAIT_V(n) asm volatile("s_waitcnt vmcnt(" #n ")" ::: "memory")
#define PG8_WAIT_L(n) asm volatile("s_waitcnt lgkmcnt(" #n ")" ::: "memory")
#define PG8_BAR __builtin_amdgcn_s_barrier()
#define PG8_SCHED __builtin_amdgcn_sched_barrier(0)
    Unit cur, nxt; int ui = 0;
    if (!S.next(0, cur)) return;
    f32x4 acc[2][2][4][2];
#pragma unroll
    for (int a = 0; a < 2; ++a)
#pragma unroll
        for (int b = 0; b < 2; ++b)
#pragma unroll
            for (int m = 0; m < 4; ++m)
#pragma unroll
                for (int n = 0; n < 2; ++n) acc[a][b][m][n] = (f32x4){0.f, 0.f, 0.f, 0.f};
    bf16x8 At[4][2], B0[2][2], B1[2][2];
    const char* cA = (const char*)g.A + (size_t)cur.pm * tstep; const char* cB = (const char*)g.Bt + (size_t)cur.pn * tstep;
    S.a_ready(cur);
    if constexpr (SP2) {
        PG8_STAGE(PG8_SB(0, 0), cB, voffB); PG8_STAGE(PG8_SB(0, 1), cB + hstep, voffB); PG8_STAGE(PG8_SA(0, 0), cA, voffA); PG8_STAGE(PG8_SA(0, 1), cA + hstep, voffA);
        if (wr == 1) PG8_BAR;
        PG8_WAIT_V(2); PG8_BAR;
        PG8_STAGE(PG8_SB(1, 0), cB + kstep, voffB); PG8_STAGE(PG8_SA(1, 0), cA + kstep, voffA); PG8_STAGE(PG8_SB(1, 1), cB + hstep + kstep, voffB);
        PG8_WAIT_V(6); PG8_BAR;
    } else {
        PG8_STAGE(PG8_SB(0, 0), cB, voffB); PG8_STAGE(PG8_SA(0, 0), cA, voffA); PG8_STAGE(PG8_SB(0, 1), cB + hstep, voffB); PG8_STAGE(PG8_SA(0, 1), cA + hstep, voffA);
        if (wr == 1) PG8_BAR;
        PG8_WAIT_V(4); PG8_BAR;
        PG8_STAGE(PG8_SB(1, 0), cB + kstep, voffB); PG8_STAGE(PG8_SA(1, 0), cA + kstep, voffA); PG8_STAGE(PG8_SB(1, 1), cB + hstep + kstep, voffB);
        PG8_WAIT_V(6); PG8_BAR;
    }
    for (;;) {
        const bool has_next = S.next(ui + 1, nxt);
        const char* nA = has_next ? (const char*)g.A + (size_t)nxt.pm * tstep : cA; const char* nB = has_next ? (const char*)g.Bt + (size_t)nxt.pn * tstep : cB;
        for (int t = 0; t < nt; t += 2) {
            const bool last = (t == nt - 2);
            const char* a1 = cA + (size_t)(t + 1) * kstep;
            const char* a2 = last ? nA : cA + (size_t)(t + 2) * kstep; const char* b2 = last ? nB : cB + (size_t)(t + 2) * kstep;
            const char* a3 = a2 + kstep; const char* b3 = b2 + kstep;
            if (last && has_next) S.a_ready(nxt);
            if constexpr (SP2) {
            PG8_LDB(B0, 0, 0); PG8_LDB(B1, 0, 1); PG8_SCHED; PG8_LDA(At, 0, 0); PG8_STAGE(PG8_SA(1, 1), a1 + hstep, voffA);
            PG8_WAIT_V(8); PG8_WAIT_L(0); PG8_BAR; PG8_MMA(0, 0, At, B0); PG8_MMA(0, 1, At, B1); PG8_BAR; PG8_SCHED;
            PG8_LDA(At, 0, 1); PG8_STAGE(PG8_SB(0, 0), b2, voffB); PG8_STAGE(PG8_SB(0, 1), b2 + hstep, voffB); PG8_STAGE(PG8_SA(0, 0), a2, voffA);
            PG8_WAIT_V(8); PG8_WAIT_L(0); PG8_BAR; PG8_MMA(1, 0, At, B0); PG8_MMA(1, 1, At, B1); PG8_BAR; PG8_SCHED;
            PG8_LDB(B0, 1, 0); PG8_LDB(B1, 1, 1); PG8_SCHED; PG8_LDA(At, 1, 0); PG8_STAGE(PG8_SA(0, 1), a2 + hstep, voffA);
            PG8_WAIT_V(8); PG8_WAIT_L(0); PG8_BAR; PG8_MMA(0, 0, At, B0); PG8_MMA(0, 1, At, B1); PG8_BAR; PG8_SCHED;
            PG8_LDA(At, 1, 1); PG8_STAGE(PG8_SB(1, 0), b3, voffB); PG8_STAGE(PG8_SB(1, 1), b3 + hstep, voffB); PG8_STAGE(PG8_SA(1, 0), a3, voffA);
            PG8_WAIT_V(8); PG8_WAIT_L(0); PG8_BAR; PG8_MMA(1, 0, At, B0); PG8_MMA(1, 1, At, B1); PG8_BAR; PG8_SCHED;
            } else {
            PG8_LDB(B0, 0, 0); PG8_SCHED; PG8_LDA(At, 0, 0); PG8_STAGE(PG8_SA(1, 1), a1 + hstep, voffA);
            PG8_WAIT_L(8); PG8_BAR; PG8_WAIT_L(0); PG8_MMA(0, 0, At, B0); PG8_BAR; PG8_SCHED;
            PG8_LDB(B1, 0, 1); PG8_STAGE(PG8_SB(0, 0), b2, voffB);
            PG8_BAR; PG8_WAIT_L(0); PG8_MMA(0, 1, At, B1); PG8_BAR;
            PG8_LDA(At, 0, 1); PG8_STAGE(PG8_SA(0, 0), a2, voffA);
            PG8_BAR; PG8_WAIT_L(0); PG8_MMA(1, 0, At, B0); PG8_BAR; PG8_SCHED;
            PG8_STAGE(PG8_SB(0, 1), b2 + hstep, voffB);
            PG8_WAIT_V(6); PG8_BAR; PG8_MMA(1, 1, At, B1); PG8_BAR;
            PG8_LDB(B0, 1, 0); PG8_SCHED; PG8_LDA(At, 1, 0); PG8_STAGE(PG8_SA(0, 1), a2 + hstep, voffA);
            PG8_WAIT_L(8); PG8_BAR; PG8_WAIT_L(0); PG8_MMA(0, 0, At, B0); PG8_BAR; PG8_SCHED;
            PG8_LDB(B1, 1, 1); PG8_STAGE(PG8_SB(1, 0), b3, voffB);
            PG8_BAR; PG8_WAIT_L(0); PG8_MMA(0, 1, At, B1); PG8_BAR;
            PG8_LDA(At, 1, 1); PG8_STAGE(PG8_SA(1, 0), a3, voffA);
            PG8_BAR; PG8_WAIT_L(0); PG8_MMA(1, 0, At, B0); PG8_BAR; PG8_SCHED;
            PG8_STAGE(PG8_SB(1, 1), b3 + hstep, voffB);
            PG8_WAIT_V(6); PG8_BAR; PG8_MMA(1, 1, At, B1); PG8_BAR;
            }
        }
        if constexpr (ALIGN_EPI) { if (wr == 0) PG8_BAR; }
        if constexpr (!Epi::AFTER_DRAIN) { E(acc, cur, wr, wc, fr, fq); S.done(cur); }
        if (!has_next) break;
#pragma unroll
        for (int a = 0; a < 2; ++a)
#pragma unroll
            for (int b = 0; b < 2; ++b)
#pragma unroll
                for (int m = 0; m < 4; ++m)
#pragma unroll
                    for (int n = 0; n < 2; ++n) acc[a][b][m][n] = (f32x4){0.f, 0.f, 0.f, 0.f};
        cur = nxt; cA = nA; cB = nB; ++ui;
        if constexpr (ALIGN_EPI) { if (wr == 1) PG8_BAR; }
    }
    PG8_WAIT_V(0);
    if constexpr (!ALIGN_EPI) { if (wr == 0) PG8_BAR; }
    PG8_BAR;
    if constexpr (Epi::AFTER_DRAIN) { E.fused(acc, cur, wr, wc, fr, fq, lds, wid, lane); S.done(cur); }
#undef PG8_SA
#undef PG8_SB
#undef PG8_STAGE
#undef PG8_LDA
#undef PG8_LDB
#undef PG8_MMA
#undef PG8_WAIT_V
#undef PG8_WAIT_L
#undef PG8_BAR
#undef PG8_SCHED
}
}

constexpr int NWAVES = 8, NTHR = 512;
constexpr int BATCH = 16, SEQ = 2048, DM = 1024, NMETA = 16;
constexpr int M = BATCH * SEQ;
constexpr int RH = 8, RDK = 64, RDV = 128;
constexpr int AQH = 16, AKH = 4, ADH = 64;
constexpr int DFF = 2816, INC = 6656;
constexpr float RMS_EPS = 1e-6f, GN_EPS = 1e-5f;
constexpr int NPH = 8;

#define GAS __attribute__((address_space(1)))
#define LAS __attribute__((address_space(3)))
typedef unsigned short bf16;
typedef unsigned v4u __attribute__((ext_vector_type(4)));
typedef unsigned v2u __attribute__((ext_vector_type(2)));
typedef float f32x4 __attribute__((ext_vector_type(4)));
typedef short bf16x8 __attribute__((ext_vector_type(8)));

constexpr size_t MiB = 1u << 20;
constexpr size_t WS_CTL = 0, CTL_ZERO_BYTES = 64 * 1024;
constexpr size_t WS_MKR = 1 * MiB;
constexpr size_t WS_MVR = WS_MKR + 16 * 512 * 2;
constexpr size_t WS_MKA = WS_MVR + 16 * 1024 * 2;
constexpr size_t WS_MVA = WS_MKA + 16 * 256 * 2;
constexpr size_t WS_SSQ1 = 2 * MiB, WS_SSQ2 = 4 * MiB;
constexpr size_t WS_WIN = 6 * MiB, WS_WBR = 19 * MiB, WS_WO = 23 * MiB, WS_WGU = 25 * MiB, WS_WD = 36 * MiB;
constexpr size_t WS_RQ = 48 * MiB, WS_RK = 80 * MiB, WS_RV = 112 * MiB, WS_RG = 176 * MiB, WS_AQ = 240 * MiB, WS_AK = 304 * MiB, WS_AV = 320 * MiB, WS_GA = 336 * MiB, WS_GB = 400 * MiB, WS_END = 464 * MiB;
constexpr size_t WS_XB = WS_RQ;
constexpr size_t WS_ACT = WS_RV;
static_assert(WS_ACT + (size_t)M * DFF * 2 <= WS_AK, "act overlay");

__device__ __forceinline__ unsigned f2bf(float f) { unsigned u = __builtin_bit_cast(unsigned, f); return (u + 0x7fffu + ((u >> 16) & 1u)) >> 16; }
__device__ __forceinline__ unsigned pk2(float lo, float hi) { return f2bf(lo) | (f2bf(hi) << 16); }
__device__ __forceinline__ float bf2f(unsigned short h) { return __builtin_bit_cast(float, (unsigned)h << 16); }
__device__ __forceinline__ float bflo(unsigned w) { return __builtin_bit_cast(float, w << 16); }
__device__ __forceinline__ float bfhi(unsigned w) { return __builtin_bit_cast(float, w & 0xffff0000u); }
__device__ __forceinline__ float wave_sum(float v) {
#pragma unroll
    for (int o = 1; o < 64; o <<= 1) v += __shfl_xor(v, o);
    return v;
}
__device__ __forceinline__ float sigmoidf_(float x) { return 1.0f / (1.0f + __expf(-x)); }

struct Args { const float* in[15]; float* out; unsigned char* ws; int ph_lo, ph_hi; };

struct Epi1 {
    static constexpr bool PERM = true, AFTER_DRAIN = false;
    unsigned char* ws;
    __device__ __forceinline__ void operator()(const pg8::f32x4 (&acc)[2][2][4][2], const pg8::Unit& u, int wr, int wc, int fr, int fq) const {
        const int pn = u.pn; size_t off; int ldc, ct;
        if (pn < 2) { off = WS_RQ; ldc = 512; ct = pn; } else if (pn < 4) { off = WS_RK; ldc = 512; ct = pn - 2; } else if (pn < 8) { off = WS_RV; ldc = 1024; ct = pn - 4; }
        else if (pn < 12) { off = WS_RG; ldc = 1024; ct = pn - 8; } else if (pn < 16) { off = WS_AQ; ldc = 1024; ct = pn - 12; } else if (pn == 16) { off = WS_AK; ldc = 256; ct = 0; }
        else if (pn == 17) { off = WS_AV; ldc = 256; ct = 0; } else if (pn < 22) { off = WS_GA; ldc = 1024; ct = pn - 18; } else { off = WS_GB; ldc = 1024; ct = pn - 22; }
        bf16* base = (bf16*)(ws + off);
        const int row0 = u.pm * 256 + wr * 64 + fr, col0 = ct * 256 + wc * 32 + 8 * fq;
#pragma unroll
        for (int ai = 0; ai < 2; ++ai)
#pragma unroll
            for (int m = 0; m < 4; ++m) { bf16* rowp = base + (size_t)(row0 + ai * 128 + m * 16) * ldc + col0;
#pragma unroll
                for (int bj = 0; bj < 2; ++bj) { const pg8::f32x4 v0 = acc[ai][bj][m][0], v1 = acc[ai][bj][m][1]; v4u w;
                    w.x = pg8::cvt_pk_bf16(v0[0], v0[1]); w.y = pg8::cvt_pk_bf16(v0[2], v0[3]); w.z = pg8::cvt_pk_bf16(v1[0], v1[1]); w.w = pg8::cvt_pk_bf16(v1[2], v1[3]);
                    *(v4u*)(rowp + bj * 128) = w; } }
    }
};
struct Epi3 {
    static constexpr bool PERM = true, AFTER_DRAIN = false;
    const bf16* ga; bf16* gb; float* part;
    __device__ __forceinline__ void operator()(const pg8::f32x4 (&acc)[2][2][4][2], const pg8::Unit& u, int wr, int wc, int fr, int fq) const {
        const bool second = u.pm >= 128; const int pm = u.pm & 127, pn = u.pn & 3;
        const int row0 = pm * 256 + wr * 64 + fr, col0 = pn * 256 + wc * 32 + 8 * fq;
#pragma unroll
        for (int ai = 0; ai < 2; ++ai)
#pragma unroll
            for (int m = 0; m < 4; ++m) { const size_t ro = (size_t)(row0 + ai * 128 + m * 16) * 1024 + col0;
#pragma unroll
                for (int bj = 0; bj < 2; ++bj) { const size_t o = ro + bj * 128; const pg8::f32x4 a0 = acc[ai][bj][m][0], a1 = acc[ai][bj][m][1];
                    const v4u g = *(const v4u*)((second ? (const bf16*)gb : ga) + o);
                    pg8::f32x4 v0, v1;
                    v0[0] = sigmoidf_(bflo(g.x)) * a0[0]; v0[1] = sigmoidf_(bfhi(g.x)) * a0[1]; v0[2] = sigmoidf_(bflo(g.y)) * a0[2]; v0[3] = sigmoidf_(bfhi(g.y)) * a0[3];
                    v1[0] = sigmoidf_(bflo(g.z)) * a1[0]; v1[1] = sigmoidf_(bfhi(g.z)) * a1[1]; v1[2] = sigmoidf_(bflo(g.w)) * a1[2]; v1[3] = sigmoidf_(bfhi(g.w)) * a1[3];
                    if (!second) { *(pg8::f32x4*)(part + o) = v0; *(pg8::f32x4*)(part + o + 4) = v1; }
                    else { const pg8::f32x4 p0 = *(const pg8::f32x4*)(part + o), p1 = *(const pg8::f32x4*)(part + o + 4); v0 += p0; v1 += p1; v4u w;
                        w.x = pg8::cvt_pk_bf16(v0[0], v0[1]); w.y = pg8::cvt_pk_bf16(v0[2], v0[3]); w.z = pg8::cvt_pk_bf16(v1[0], v1[1]); w.w = pg8::cvt_pk_bf16(v1[2], v1[3]);
                        *(v4u*)(gb + o) = w; } } }
    }
};
struct Sched3 {
    pg8::StaticOrder S;
    __device__ bool next(int i, pg8::Unit& u) const { if (!S.next(i >> 1, u)) return false; if (i & 1) { u.pm += 128; u.pn += 4; } return true; }
    __device__ __forceinline__ void a_ready(const pg8::Unit&) const {}
    __device__ __forceinline__ void done(const pg8::Unit&) const {}
};
template <bool FIRST> struct EpiRes {
    static constexpr bool PERM = true, AFTER_DRAIN = false;
    const float* base; float* out; bf16* xb; float* ssq;
    __device__ __forceinline__ void operator()(const pg8::f32x4 (&acc)[2][2][4][2], const pg8::Unit& u, int wr, int wc, int fr, int fq) const {
        const int row0 = u.pm * 256 + wr * 64 + fr, col0 = u.pn * 256 + wc * 32 + 8 * fq;
#pragma unroll
        for (int ai = 0; ai < 2; ++ai)
#pragma unroll
            for (int m = 0; m < 4; ++m) { const int r = row0 + ai * 128 + m * 16; const size_t ro = (size_t)r * 1024 + col0; float ss = 0.f;
#pragma unroll
                for (int bj = 0; bj < 2; ++bj) { const size_t o = ro + bj * 128;
                    pg8::f32x4 v0 = *(const pg8::f32x4*)(base + o) + acc[ai][bj][m][0], v1 = *(const pg8::f32x4*)(base + o + 4) + acc[ai][bj][m][1];
                    *(pg8::f32x4*)(out + o) = v0; *(pg8::f32x4*)(out + o + 4) = v1;
                    ss += (v0[0] * v0[0] + v0[1] * v0[1]) + (v0[2] * v0[2] + v0[3] * v0[3]) + (v1[0] * v1[0] + v1[1] * v1[1]) + (v1[2] * v1[2] + v1[3] * v1[3]);
                    if (FIRST) { v4u w; w.x = pg8::cvt_pk_bf16(v0[0], v0[1]); w.y = pg8::cvt_pk_bf16(v0[2], v0[3]); w.z = pg8::cvt_pk_bf16(v1[0], v1[1]); w.w = pg8::cvt_pk_bf16(v1[2], v1[3]); *(v4u*)(xb + o) = w; } }
                ss += __shfl_xor(ss, 16); ss += __shfl_xor(ss, 32);
                if (fq == 0) ssq[(size_t)r * 16 + u.pn * 4 + wc] = ss; }
    }
};
struct Epi5 {
    static constexpr bool PERM = true, AFTER_DRAIN = false;
    bf16* act; const float* ssq;
    __device__ __forceinline__ void operator()(const pg8::f32x4 (&acc)[2][2][4][2], const pg8::Unit& u, int wr, int wc, int fr, int fq) const {
        const int row0 = u.pm * 256 + wr * 64 + fr, ch0 = u.pn * 128 + wc * 32 + 8 * fq;
#pragma unroll
        for (int ai = 0; ai < 2; ++ai)
#pragma unroll
            for (int m = 0; m < 4; ++m) { const int r = row0 + ai * 128 + m * 16;
                const pg8::f32x4* sp = (const pg8::f32x4*)(ssq + (size_t)r * 16); const pg8::f32x4 s0 = sp[0], s1 = sp[1], s2 = sp[2], s3 = sp[3];
                const float tot = ((s0[0] + s0[1]) + (s0[2] + s0[3])) + ((s1[0] + s1[1]) + (s1[2] + s1[3])) + ((s2[0] + s2[1]) + (s2[2] + s2[3])) + ((s3[0] + s3[1]) + (s3[2] + s3[3]));
                const float rstd = 1.0f / sqrtf(tot * (1.0f / 1024.0f) + RMS_EPS);
                float o[8];
#pragma unroll
                for (int n = 0; n < 2; ++n)
#pragma unroll
                    for (int j = 0; j < 4; ++j) { const float a = acc[ai][0][m][n][j] * rstd, b = acc[ai][1][m][n][j] * rstd; o[n * 4 + j] = a * sigmoidf_(a) * b; }
                v4u w; w.x = pg8::cvt_pk_bf16(o[0], o[1]); w.y = pg8::cvt_pk_bf16(o[2], o[3]); w.z = pg8::cvt_pk_bf16(o[4], o[5]); w.w = pg8::cvt_pk_bf16(o[6], o[7]);
                *(v4u*)(act + (size_t)r * DFF + ch0) = w; }
    }
};

__device__ __forceinline__ void p0_transpose_item(const float* W, int K, int N, bf16* WT, int k0, int n0, int drow0, const float* gk, LAS float* scr, int lane) {
#pragma unroll 8
    for (int i = 0; i < 32; ++i) { const int kk = 2 * i + (lane >> 5); float v = W[(size_t)(k0 + kk) * N + n0 + (lane & 31)]; if (gk) v *= gk[k0 + kk]; scr[kk * 33 + (lane & 31)] = v; }
    asm volatile("s_waitcnt lgkmcnt(0)" ::: "memory");
    const int c = lane & 7;
#pragma unroll
    for (int j = 0; j < 4; ++j) { const int n = (lane >> 3) + 8 * j; const LAS float* s = scr + (8 * c) * 33 + n;
        v4u o; o.x = pk2(s[0 * 33], s[1 * 33]); o.y = pk2(s[2 * 33], s[3 * 33]); o.z = pk2(s[4 * 33], s[5 * 33]); o.w = pk2(s[6 * 33], s[7 * 33]);
        *(v4u*)(WT + (size_t)(drow0 + n) * K + k0 + 8 * c) = o; }
    asm volatile("s_waitcnt lgkmcnt(0)" ::: "memory");
}
__device__ __forceinline__ void p0_prologue(const Args& a, LAS unsigned char* lds, int tid, int lane, int wave, int G) {
    unsigned char* ws = a.ws;
    LAS float* scr = (LAS float*)(lds + wave * 16384);
    const int gw = blockIdx.x * NWAVES + wave, NGW = G * NWAVES;
    constexpr int I_IN = 16 * 208, I_BR = 16 * 32, I_O = 16 * 32, I_GU = 16 * 176, I_D = 44 * 32;
    constexpr int NITEMS = I_IN + 2 * I_BR + I_O + I_GU + I_D;
    for (int it = gw; it < NITEMS; it += NGW) {
        int r = it;
        if (r < I_IN) { const int kb = r / 208, nb = r % 208; p0_transpose_item(a.in[2], 1024, INC, (bf16*)(ws + WS_WIN), 64 * kb, 32 * nb, 32 * nb, nullptr, scr, lane); continue; } r -= I_IN;
        if (r < I_BR) { const int kb = r / 32, nb = r % 32; p0_transpose_item(a.in[7], 1024, 1024, (bf16*)(ws + WS_WBR), 64 * kb, 32 * nb, 32 * nb, nullptr, scr, lane); continue; } r -= I_BR;
        if (r < I_BR) { const int kb = r / 32, nb = r % 32; p0_transpose_item(a.in[8], 1024, 1024, (bf16*)(ws + WS_WBR), 64 * kb, 32 * nb, 1024 + 32 * nb, nullptr, scr, lane); continue; } r -= I_BR;
        if (r < I_O) { const int kb = r / 32, nb = r % 32; p0_transpose_item(a.in[9], 1024, 1024, (bf16*)(ws + WS_WO), 64 * kb, 32 * nb, 32 * nb, nullptr, scr, lane); continue; } r -= I_O;
        if (r < I_GU) { const int kb = r / 176, nb = r % 176; const int n0 = 32 * nb, which = n0 / DFF, ch = n0 % DFF;
            p0_transpose_item(a.in[12], 1024, 2 * DFF, (bf16*)(ws + WS_WGU), 64 * kb, n0, (ch / 128) * 256 + which * 128 + (ch % 128), a.in[11], scr, lane); continue; } r -= I_GU;
        { const int kb = r / 32, nb = r % 32; p0_transpose_item(a.in[13], DFF, 1024, (bf16*)(ws + WS_WD), 64 * kb, 32 * nb, 32 * nb, nullptr, scr, lane); }
    }
    {
        const f32x4* gp = (const f32x4*)a.in[10] + lane; f32x4 g[4];
#pragma unroll
        for (int j = 0; j < 4; ++j) g[j] = gp[64 * j];
        bf16* hb = (bf16*)a.out;
        for (int m = gw; m < M; m += NGW) {
            const f32x4* xr = (const f32x4*)(a.in[0] + (size_t)m * DM) + lane; f32x4 v[4]; float s = 0.f;
#pragma unroll
            for (int j = 0; j < 4; ++j) { v[j] = xr[64 * j]; s += (v[j].x * v[j].x + v[j].y * v[j].y) + (v[j].z * v[j].z + v[j].w * v[j].w); }
            const float rstd = 1.0f / sqrtf(wave_sum(s) * (1.0f / DM) + RMS_EPS);
            v2u* o8 = (v2u*)(hb + (size_t)m * DM) + lane;
#pragma unroll
            for (int j = 0; j < 4; ++j) { v2u o; o.x = pk2(v[j].x * rstd * g[j].x, v[j].y * rstd * g[j].y); o.y = pk2(v[j].z * rstd * g[j].z, v[j].w * rstd * g[j].w); o8[64 * j] = o; }
        }
    }
    if (blockIdx.x < 64) {
        __syncthreads();
        LAS float* hm = (LAS float*)lds;
        LAS float* red = (LAS float*)(lds + 65536);
        {
            const f32x4* gp = (const f32x4*)a.in[10] + lane;
#pragma unroll
            for (int rr = 0; rr < 2; ++rr) { const int r = wave * 2 + rr; const f32x4* xr = (const f32x4*)(a.in[1] + (size_t)r * DM) + lane; f32x4 v[4]; float s = 0.f;
#pragma unroll
                for (int j = 0; j < 4; ++j) { v[j] = xr[64 * j]; s += (v[j].x * v[j].x + v[j].y * v[j].y) + (v[j].z * v[j].z + v[j].w * v[j].w); }
                const float rstd = 1.0f / sqrtf(wave_sum(s) * (1.0f / DM) + RMS_EPS);
#pragma unroll
                for (int j = 0; j < 4; ++j) { const f32x4 g = gp[64 * j]; f32x4 o; o.x = v[j].x * rstd * g.x; o.y = v[j].y * rstd * g.y; o.z = v[j].z * rstd * g.z; o.w = v[j].w * rstd * g.w;
                    *(LAS f32x4*)(hm + r * 1024 + (64 * j + lane) * 4) = o; } }
        }
        __syncthreads();
        const int cgi = blockIdx.x >> 1, chalf = (blockIdx.x & 1) * 32; int src, dcol, ld; size_t dsto;
        if (cgi < 8) { src = 512 + 64 * cgi; dsto = WS_MKR; ld = 512; dcol = 64 * cgi; }
        else if (cgi < 24) { src = 1024 + 64 * (cgi - 8); dsto = WS_MVR; ld = 1024; dcol = 64 * (cgi - 8); }
        else if (cgi < 28) { src = 4096 + 64 * (cgi - 24); dsto = WS_MKA; ld = 256; dcol = 64 * (cgi - 24); }
        else { src = 4352 + 64 * (cgi - 28); dsto = WS_MVA; ld = 256; dcol = 64 * (cgi - 28); }
        float acc[16];
#pragma unroll
        for (int m = 0; m < 16; ++m) acc[m] = 0.f;
        const int col = lane & 31, kh4 = (lane >> 5) * 4;
        const float* wp = a.in[2] + src + chalf + col;
#pragma unroll 4
        for (int it = 0; it < 16; ++it) {
            const int k = 128 * wave + 8 * it + kh4;
            const float w0 = wp[(size_t)k * INC], w1 = wp[(size_t)(k + 1) * INC], w2 = wp[(size_t)(k + 2) * INC], w3 = wp[(size_t)(k + 3) * INC];
#pragma unroll
            for (int m = 0; m < 16; ++m) { const f32x4 hv = *(const LAS f32x4*)(hm + m * 1024 + k); acc[m] += (hv.x * w0 + hv.y * w1) + (hv.z * w2 + hv.w * w3); }
        }
#pragma unroll
        for (int m = 0; m < 16; ++m) { acc[m] += __shfl_xor(acc[m], 32); if (lane < 32) red[(wave * 16 + m) * 32 + col] = acc[m]; }
        __syncthreads();
        {
            const int m = tid >> 5, c = tid & 31; float s = 0.f;
#pragma unroll
            for (int w = 0; w < 8; ++w) s += red[(w * 16 + m) * 32 + c];
            ((bf16*)(ws + dsto))[m * ld + dcol + chalf + c] = (bf16)f2bf(s);
        }
        __syncthreads();
    }
}

__device__ __forceinline__ float log2_sigmoid(float x) { return -log1pf(__expf(-x)) * 1.4426950408889634f; }
__device__ __forceinline__ void naive_retention(const Args& a, int tid, int G) {
    unsigned char* ws = a.ws;
    const bf16* rq = (const bf16*)(ws + WS_RQ); const bf16* rk = (const bf16*)(ws + WS_RK); const bf16* rv = (const bf16*)(ws + WS_RV); bf16* rg = (bf16*)(ws + WS_RG);
    const bf16* mk = (const bf16*)(ws + WS_MKR); const bf16* mv = (const bf16*)(ws + WS_MVR);
    for (int it = blockIdx.x; it < BATCH * RH * 8; it += G) {
        const int b = it / (RH * 8), h = (it / 8) % RH, t = (it % 8) * 256 + (tid >> 1), half = tid & 1;
        const float l2f = log2_sigmoid(a.in[3][h]), l2b = log2_sigmoid(a.in[4][h]);
        const size_t row = (size_t)b * SEQ + t;
        v4u qp[8];
#pragma unroll
        for (int c = 0; c < 8; ++c) qp[c] = *(const v4u*)(rq + row * 512 + h * 64 + c * 8);
        float acc[64];
#pragma unroll
        for (int e = 0; e < 64; ++e) acc[e] = 0.f;
        for (int s = -NMETA; s < SEQ; ++s) {
            const bf16* kp = s < 0 ? mk + (size_t)(s + NMETA) * 512 + h * 64 : rk + ((size_t)b * SEQ + s) * 512 + h * 64;
            const bf16* vp = (s < 0 ? mv + (size_t)(s + NMETA) * 1024 + h * 128 : rv + ((size_t)b * SEQ + s) * 1024 + h * 128) + half * 64;
            float d = 0.f;
#pragma unroll
            for (int c = 0; c < 8; ++c) { const v4u kk = *(const v4u*)(kp + c * 8); const v4u qq = qp[c];
                d += bflo(qq.x) * bflo(kk.x) + bfhi(qq.x) * bfhi(kk.x) + bflo(qq.y) * bflo(kk.y) + bfhi(qq.y) * bfhi(kk.y) + bflo(qq.z) * bflo(kk.z) + bfhi(qq.z) * bfhi(kk.z) + bflo(qq.w) * bflo(kk.w) + bfhi(qq.w) * bfhi(kk.w); }
            const int dist = t - s;
            const float w = d * 0.125f * exp2f(dist >= 0 ? (float)dist * l2f : (float)(-dist) * l2b);
#pragma unroll
            for (int c = 0; c < 8; ++c) { const v4u vv = *(const v4u*)(vp + c * 8);
                acc[c * 8 + 0] += w * bflo(vv.x); acc[c * 8 + 1] += w * bfhi(vv.x); acc[c * 8 + 2] += w * bflo(vv.y); acc[c * 8 + 3] += w * bfhi(vv.y);
                acc[c * 8 + 4] += w * bflo(vv.z); acc[c * 8 + 5] += w * bfhi(vv.z); acc[c * 8 + 6] += w * bflo(vv.w); acc[c * 8 + 7] += w * bfhi(vv.w); }
        }
        float mu = 0.f;
#pragma unroll
        for (int e = 0; e < 64; ++e) mu += acc[e];
        mu += __shfl_xor(mu, 1); mu *= (1.0f / 128.0f); float var = 0.f;
#pragma unroll
        for (int e = 0; e < 64; ++e) { const float dd = acc[e] - mu; var += dd * dd; }
        var += __shfl_xor(var, 1);
        const float rstd = 1.0f / sqrtf(var * (1.0f / 128.0f) + GN_EPS);
        const float* gn = a.in[5] + h * 128 + half * 64;
#pragma unroll
        for (int c = 0; c < 8; ++c) { bf16* gp = rg + row * 1024 + h * 128 + half * 64 + c * 8; const v4u gg = *(const v4u*)gp; float o[8];
            const float gv[8] = {bflo(gg.x), bfhi(gg.x), bflo(gg.y), bfhi(gg.y), bflo(gg.z), bfhi(gg.z), bflo(gg.w), bfhi(gg.w)};
#pragma unroll
            for (int j = 0; j < 8; ++j) o[j] = gv[j] * sigmoidf_(gv[j]) * ((acc[c * 8 + j] - mu) * rstd * gn[c * 8 + j]);
            v4u w4; w4.x = pk2(o[0], o[1]); w4.y = pk2(o[2], o[3]); w4.z = pk2(o[4], o[5]); w4.w = pk2(o[6], o[7]); *(v4u*)gp = w4; }
    }
}
__device__ __forceinline__ void naive_attention(const Args& a, int tid, int G) {
    unsigned char* ws = a.ws;
    bf16* aq = (bf16*)(ws + WS_AQ); const bf16* ak = (const bf16*)(ws + WS_AK); const bf16* av = (const bf16*)(ws + WS_AV);
    const bf16* mk = (const bf16*)(ws + WS_MKA); const bf16* mv = (const bf16*)(ws + WS_MVA);
    for (int it = blockIdx.x; it < BATCH * AQH * 4; it += G) {
        const int b = it / (AQH * 4), qh = (it / 4) % AQH, t = (it % 4) * 512 + tid, kh = qh / 4;
        const float slope = exp2f(-0.5f * (float)(qh + 1));
        const size_t row = (size_t)b * SEQ + t;
        float q[64];
#pragma unroll
        for (int c = 0; c < 8; ++c) { const v4u qq = *(const v4u*)(aq + row * 1024 + qh * 64 + c * 8);
            q[c * 8 + 0] = bflo(qq.x) * 0.125f; q[c * 8 + 1] = bfhi(qq.x) * 0.125f; q[c * 8 + 2] = bflo(qq.y) * 0.125f; q[c * 8 + 3] = bfhi(qq.y) * 0.125f;
            q[c * 8 + 4] = bflo(qq.z) * 0.125f; q[c * 8 + 5] = bfhi(qq.z) * 0.125f; q[c * 8 + 6] = bflo(qq.w) * 0.125f; q[c * 8 + 7] = bfhi(qq.w) * 0.125f; }
        float mx = a.in[6][qh], l = 1.0f, acc[64];
#pragma unroll
        for (int e = 0; e < 64; ++e) acc[e] = 0.f;
        for (int j = -NMETA; j <= 256; ++j) {
            const int s = t - 128 + j;
            if (j >= 0 && (s < 0 || s >= SEQ)) continue;
            const bf16* kp = j < 0 ? mk + (size_t)(j + NMETA) * 256 + kh * 64 : ak + ((size_t)b * SEQ + s) * 256 + kh * 64;
            const bf16* vp = j < 0 ? mv + (size_t)(j + NMETA) * 256 + kh * 64 : av + ((size_t)b * SEQ + s) * 256 + kh * 64;
            float d = 0.f;
#pragma unroll
            for (int c = 0; c < 8; ++c) { const v4u kk = *(const v4u*)(kp + c * 8);
                d += q[c * 8 + 0] * bflo(kk.x) + q[c * 8 + 1] * bfhi(kk.x) + q[c * 8 + 2] * bflo(kk.y) + q[c * 8 + 3] * bfhi(kk.y) + q[c * 8 + 4] * bflo(kk.z) + q[c * 8 + 5] * bfhi(kk.z) + q[c * 8 + 6] * bflo(kk.w) + q[c * 8 + 7] * bfhi(kk.w); }
            if (j >= 0) { const int dist = j < 128 ? 128 - j : j - 128; d -= slope * (float)dist; }
            const float mn = fmaxf(mx, d), f = __expf(mx - mn), p = __expf(d - mn); mx = mn; l = l * f + p;
#pragma unroll
            for (int c = 0; c < 8; ++c) { const v4u vv = *(const v4u*)(vp + c * 8);
                acc[c * 8 + 0] = acc[c * 8 + 0] * f + p * bflo(vv.x); acc[c * 8 + 1] = acc[c * 8 + 1] * f + p * bfhi(vv.x); acc[c * 8 + 2] = acc[c * 8 + 2] * f + p * bflo(vv.y); acc[c * 8 + 3] = acc[c * 8 + 3] * f + p * bfhi(vv.y);
                acc[c * 8 + 4] = acc[c * 8 + 4] * f + p * bflo(vv.z); acc[c * 8 + 5] = acc[c * 8 + 5] * f + p * bfhi(vv.z); acc[c * 8 + 6] = acc[c * 8 + 6] * f + p * bflo(vv.w); acc[c * 8 + 7] = acc[c * 8 + 7] * f + p * bfhi(vv.w); }
        }
        const float il = 1.0f / l;
#pragma unroll
        for (int c = 0; c < 8; ++c) { v4u w4; w4.x = pk2(acc[c * 8 + 0] * il, acc[c * 8 + 1] * il); w4.y = pk2(acc[c * 8 + 2] * il, acc[c * 8 + 3] * il); w4.z = pk2(acc[c * 8 + 4] * il, acc[c * 8 + 5] * il); w4.w = pk2(acc[c * 8 + 6] * il, acc[c * 8 + 7] * il);
            *(v4u*)(aq + row * 1024 + qh * 64 + c * 8) = w4; }
    }
}

typedef float f32x16 __attribute__((ext_vector_type(16)));
typedef float f32x2_t __attribute__((ext_vector_type(2)));
typedef __bf16 bf16x2_t __attribute__((ext_vector_type(2)));
__device__ __forceinline__ unsigned cvtpk(float lo, float hi) { f32x2_t v = {lo, hi}; bf16x2_t b = __builtin_convertvector(v, bf16x2_t); return __builtin_bit_cast(unsigned, b); }
__device__ __forceinline__ bf16x8 pack8(const f32x16& x, int s) { v4u p; p.x = cvtpk(x[8 * s], x[8 * s + 1]); p.y = cvtpk(x[8 * s + 2], x[8 * s + 3]); p.z = cvtpk(x[8 * s + 4], x[8 * s + 5]); p.w = cvtpk(x[8 * s + 6], x[8 * s + 7]); return __builtin_bit_cast(bf16x8, p); }
__device__ __forceinline__ int crow(int reg, int h) { return (reg & 3) + 8 * (reg >> 2) + 4 * h; }
__device__ __forceinline__ int perm16(int x) { return (x & 3) | ((x & 4) << 1) | ((x & 8) >> 1); }
#define MFMA32(a, b, c) __builtin_amdgcn_mfma_f32_32x32x16_bf16((a), (b), (c), 0, 0, 0)
constexpr int AT_KROW = 144, AT_VROW = 848, AT_KIMG = 0, AT_VT = 416 * AT_KROW;
static_assert(AT_VT + 64 * AT_VROW <= 131072, "attention LDS");

__device__ __forceinline__ void attn_unit(const Args& a, LAS unsigned char* lds, int unit, int tid, int lane, int wave, bf16* attbase) {
    unsigned char* ws = a.ws;
    bf16* aq = (bf16*)(ws + WS_AQ); const bf16* ak = (const bf16*)(ws + WS_AK); const bf16* av = (const bf16*)(ws + WS_AV);
    const bf16* mk = (const bf16*)(ws + WS_MKA); const bf16* mv = (const bf16*)(ws + WS_MVA);
    const int n = unit & 15, kh = (unit >> 4) & 3, b = unit >> 6;
    const size_t rowb = (size_t)b * SEQ;
    for (int i = tid; i < 400 * 8; i += NTHR) {
        const int row = i >> 3, pc = i & 7; const bf16* src; int irow;
        if (row < 16) { src = mk + (size_t)row * 256 + kh * 64 + pc * 8; irow = row; }
        else { const int j = row - 16, t = 128 * (n - 1) + j; if (t < 0 || t >= SEQ) continue; src = ak + (rowb + t) * 256 + kh * 64 + pc * 8; irow = 32 + j; }
        *(LAS v4u*)(lds + AT_KIMG + irow * AT_KROW + pc * 16) = *(const v4u*)src;
    }
    for (int i = tid; i < 200 * 8; i += NTHR) {
        const int pr = i >> 3, pc = i & 7; const bf16* src; int pos;
        if (pr < 8) { src = mv + (size_t)(2 * pr) * 256 + kh * 64 + pc * 8; pos = perm16(2 * pr); }
        else { const int j = 2 * (pr - 8), t = 128 * (n - 1) + j; if (t < 0 || t >= SEQ) continue; src = av + (rowb + t) * 256 + kh * 64 + pc * 8; pos = 32 + (j & ~15) + perm16(j & 15); }
        const v4u v0 = *(const v4u*)src, v1 = *(const v4u*)(src + 256);
        LAS unsigned char* dst = lds + AT_VT + (pc * 8) * AT_VROW + pos * 2;
        *(LAS unsigned*)(dst + 0 * AT_VROW) = (v0.x & 0xffffu) | (v1.x << 16); *(LAS unsigned*)(dst + 1 * AT_VROW) = (v0.x >> 16) | (v1.x & 0xffff0000u);
        *(LAS unsigned*)(dst + 2 * AT_VROW) = (v0.y & 0xffffu) | (v1.y << 16); *(LAS unsigned*)(dst + 3 * AT_VROW) = (v0.y >> 16) | (v1.y & 0xffff0000u);
        *(LAS unsigned*)(dst + 4 * AT_VROW) = (v0.z & 0xffffu) | (v1.z << 16); *(LAS unsigned*)(dst + 5 * AT_VROW) = (v0.z >> 16) | (v1.z & 0xffff0000u);
        *(LAS unsigned*)(dst + 6 * AT_VROW) = (v0.w & 0xffffu) | (v1.w << 16); *(LAS unsigned*)(dst + 7 * AT_VROW) = (v0.w >> 16) | (v1.w & 0xffff0000u);
    }
    __syncthreads();
    const int r = lane & 31, h = lane >> 5;
    constexpr float L2E = 1.4426950408889634f;
#pragma unroll 1
    for (int rep = 0; rep < 2; ++rep) {
        const int tt = wave + 8 * rep, g = tt >> 2, p = tt & 3, qh = kh * 4 + g;
        const size_t qrow = rowb + 128 * n + 32 * p + r;
        bf16* qp = aq + qrow * 1024 + qh * 64; bf16* op = attbase + qrow * 1024 + qh * 64;
        bf16x8 qf[4];
#pragma unroll
        for (int ds = 0; ds < 4; ++ds) qf[ds] = *(const bf16x8*)(qp + 16 * ds + 8 * h);
        const float slope2 = exp2f(-0.5f * (float)(qh + 1)) * L2E, sc = 0.125f * L2E;
        float m = a.in[6][qh] * L2E, l = h == 0 ? 1.0f : 0.0f;
        f32x16 o0, o1;
#pragma unroll
        for (int i = 0; i < 16; ++i) { o0[i] = 0.f; o1[i] = 0.f; }
#pragma unroll 1
        for (int cc = -1; cc < 9; ++cc) {
            const int cj = p + cc;
            if (cc >= 0) { const int blk = n - 1 + (cj >> 2); if (blk < 0 || blk > 15) continue; }
            const int rowbase = cc < 0 ? 0 : 32 + 32 * cj;
            f32x16 s;
#pragma unroll
            for (int i = 0; i < 16; ++i) s[i] = 0.f;
            const LAS unsigned char* kp = lds + AT_KIMG + (rowbase + r) * AT_KROW + 16 * h;
#pragma unroll
            for (int ds = 0; ds < 4; ++ds) s = MFMA32(*(const LAS bf16x8*)(kp + 32 * ds), qf[ds], s);
            float mc = -INFINITY;
            {
                const float dq0 = (float)(32 * cc + 4 * h - 128 - r), sl = cc < 0 ? 0.f : slope2, lim = (cc == 0 || cc == 8) ? 128.0f : 1e9f;
#pragma unroll
                for (int i = 0; i < 16; ++i) { const float dq = fabsf(dq0 + (float)((i & 3) + 8 * (i >> 2))); float t = s[i] * sc - sl * dq;
                    t = dq > lim ? -INFINITY : t;
                    if (i >= 8 && cc < 0) t = -INFINITY;
                    s[i] = t; mc = fmaxf(mc, t); }
            }
            mc = fmaxf(mc, __shfl_xor(mc, 32));
            const float mn = fmaxf(m, mc);
            if (__any(mn > m)) { const float al = exp2f(m - mn); l *= al;
#pragma unroll
                for (int i = 0; i < 16; ++i) { o0[i] *= al; o1[i] *= al; } }
            m = mn;
            float ls = 0.f;
#pragma unroll
            for (int i = 0; i < 16; ++i) { s[i] = exp2f(s[i] - m); ls += s[i]; }
            l += ls;
            const LAS unsigned char* vp = lds + AT_VT + r * AT_VROW + (rowbase + 8 * h) * 2;
            {
                const bf16x8 pk = pack8(s, 0);
                o0 = MFMA32(*(const LAS bf16x8*)(vp), pk, o0);
                o1 = MFMA32(*(const LAS bf16x8*)(vp + 32 * AT_VROW), pk, o1);
            }
            if (cc >= 0) {
                const bf16x8 pk = pack8(s, 1);
                o0 = MFMA32(*(const LAS bf16x8*)(vp + 32), pk, o0);
                o1 = MFMA32(*(const LAS bf16x8*)(vp + 32 * AT_VROW + 32), pk, o1);
            }
        }
        l += __shfl_xor(l, 32);
        const float il = 1.0f / l;
#pragma unroll
        for (int gq = 0; gq < 4; ++gq) {
            v2u w0, w1;
            w0.x = cvtpk(o0[4 * gq] * il, o0[4 * gq + 1] * il); w0.y = cvtpk(o0[4 * gq + 2] * il, o0[4 * gq + 3] * il);
            w1.x = cvtpk(o1[4 * gq] * il, o1[4 * gq + 1] * il); w1.y = cvtpk(o1[4 * gq + 2] * il, o1[4 * gq + 3] * il);
            *(v2u*)(op + 8 * gq + 4 * h) = w0; *(v2u*)(op + 32 + 8 * gq + 4 * h) = w1;
        }
    }
    __syncthreads();
}
__device__ __forceinline__ void attn_phase(const Args& a, LAS unsigned char* lds, int tid, int lane, int wave, int G, bf16* attbase) {
    for (int u = blockIdx.x; u < BATCH * AKH * 16; u += G) attn_unit(a, lds, u, tid, lane, wave, attbase);
}

constexpr size_t WS_SB = 464 * MiB;
constexpr int RT_ROWK = 144, RT_ROWT = 272;
constexpr int RT_KIMG = 0, RT_KT = RT_KIMG + 128 * RT_ROWK, RT_VT = RT_KT + 64 * RT_ROWT, RT_STF = RT_VT + 128 * RT_ROWT, RT_STB = RT_STF + 128 * RT_ROWK, RT_XCH = RT_STB + 128 * RT_ROWK, RT_END = RT_XCH + 2048;
static_assert(RT_END <= 131072, "retention LDS");

__device__ __forceinline__ void rt_put_t(LAS unsigned char* img, int j0, int c0, v4u r0, v4u r1, float s0, float s1, bool scale) {
    const int pos = (j0 & ~15) + perm16(j0 & 15);
    LAS unsigned char* dst = img + c0 * RT_ROWT + pos * 2;
    const unsigned a[4] = {r0.x, r0.y, r0.z, r0.w}, bq[4] = {r1.x, r1.y, r1.z, r1.w};
#pragma unroll
    for (int q = 0; q < 4; ++q) {
        unsigned lo, hi;
        if (scale) { lo = cvtpk(bflo(a[q]) * s0, bflo(bq[q]) * s1); hi = cvtpk(bfhi(a[q]) * s0, bfhi(bq[q]) * s1); }
        else { lo = (a[q] & 0xffffu) | (bq[q] << 16); hi = (a[q] >> 16) | (bq[q] & 0xffff0000u); }
        *(LAS unsigned*)(dst + (2 * q) * RT_ROWT) = lo; *(LAS unsigned*)(dst + (2 * q + 1) * RT_ROWT) = hi;
    }
}
__device__ __forceinline__ void rt_tile_to_img(LAS unsigned char* img, const f32x16& t, int eb, int db, int r, int h) {
#pragma unroll
    for (int i = 0; i < 16; ++i) *(LAS unsigned short*)(img + (32 * eb + crow(i, h)) * RT_ROWK + (32 * db + r) * 2) = (unsigned short)f2bf(t[i]);
}

__device__ __forceinline__ void ret_unit(const Args& a, LAS unsigned char* lds, int unit, int tid, int lane, int wave, bf16* retbase) {
    unsigned char* ws = a.ws;
    const int b = unit >> 3, hd = unit & 7;
    const size_t rowb = (size_t)b * SEQ;
    const bf16* rq = (const bf16*)(ws + WS_RQ) + hd * 64; const bf16* rk = (const bf16*)(ws + WS_RK) + hd * 64; const bf16* rv = (const bf16*)(ws + WS_RV) + hd * 128; bf16* rg = (bf16*)(ws + WS_RG) + hd * 128;
    const bf16* mk = (const bf16*)(ws + WS_MKR) + hd * 64; const bf16* mv = (const bf16*)(ws + WS_MVR) + hd * 128;
    bf16* sbg = (bf16*)(ws + WS_SB) + (size_t)unit * 16 * 8192;
    const float l2f = log2_sigmoid(a.in[3][hd]), l2b = log2_sigmoid(a.in[4][hd]);
    const float cdf = exp2f(128.0f * l2f), cdb = exp2f(128.0f * l2b);
    const int r = lane & 31, h = lane >> 5;
    const int kpr = tid >> 3, kpc = tid & 7, vpr = tid >> 3, vpc = tid & 7;
    const int kj0 = 2 * kpr;
    const float kf0 = exp2f(l2f * (float)(127 - kj0) - 3.0f), kf1 = exp2f(l2f * (float)(126 - kj0) - 3.0f);
    const float kb0 = exp2f(l2b * (float)kj0 - 3.0f), kb1 = exp2f(l2b * (float)(kj0 + 1) - 3.0f);
    const int eb_s = wave >> 1, db_s = wave & 1;
    const LAS unsigned char* vtA = lds + RT_VT + (32 * eb_s + r) * RT_ROWT + 16 * h;
    const LAS unsigned char* ktB = lds + RT_KT + (32 * db_s + r) * RT_ROWT + 16 * h;
    f32x16 tile;
#ifndef RT_SKIP_P1
#pragma unroll
    for (int i = 0; i < 16; ++i) tile[i] = 0.f;
#pragma unroll 1
    for (int c = 15; c >= 0; --c) {
        rt_tile_to_img(lds + RT_STB, tile, eb_s, db_s, r, h);
        if (c > 0) {
            const bf16* kp = rk + (rowb + 128 * c + kj0) * 512 + kpc * 8; const v4u k0 = *(const v4u*)kp, k1 = *(const v4u*)(kp + 512);
            rt_put_t(lds + RT_KT, kj0, kpc * 8, k0, k1, kb0, kb1, true);
            const bf16* vp = rv + (rowb + 128 * c + 2 * vpr) * 1024 + vpc * 8;
            const v4u v0 = *(const v4u*)vp, v1 = *(const v4u*)(vp + 1024), v2 = *(const v4u*)(vp + 64), v3 = *(const v4u*)(vp + 1024 + 64);
            rt_put_t(lds + RT_VT, 2 * vpr, vpc * 8, v0, v1, 0.f, 0.f, false); rt_put_t(lds + RT_VT, 2 * vpr, vpc * 8 + 64, v2, v3, 0.f, 0.f, false);
        }
        __syncthreads();
        {
            bf16* dst = sbg + (size_t)c * 8192;
#pragma unroll
            for (int q = 0; q < 2; ++q) { const int pcs = tid + 512 * q, row = pcs >> 3, pc = pcs & 7; *(v4u*)(dst + row * 64 + pc * 8) = *(const LAS v4u*)(lds + RT_STB + row * RT_ROWK + pc * 16); }
        }
        if (c > 0) {
#pragma unroll
            for (int i = 0; i < 16; ++i) tile[i] *= cdb;
#pragma unroll
            for (int s = 0; s < 8; ++s) tile = MFMA32(*(const LAS bf16x8*)(vtA + 32 * s), *(const LAS bf16x8*)(ktB + 32 * s), tile);
        }
        __syncthreads();
    }
#endif
#pragma unroll
    for (int i = 0; i < 16; ++i) tile[i] = 0.f;
    {
        v4u k0 = {0u, 0u, 0u, 0u}, k1 = k0, v0 = k0, v1 = k0, v2 = k0, v3 = k0;
        if (kj0 >= 112) { const bf16* kp = mk + (size_t)(kj0 - 112) * 512 + kpc * 8; k0 = *(const v4u*)kp; k1 = *(const v4u*)(kp + 512);
            const bf16* vp = mv + (size_t)(kj0 - 112) * 1024 + vpc * 8; v0 = *(const v4u*)vp; v1 = *(const v4u*)(vp + 1024); v2 = *(const v4u*)(vp + 64); v3 = *(const v4u*)(vp + 1024 + 64); }
        rt_put_t(lds + RT_KT, kj0, kpc * 8, k0, k1, kf0, kf1, true);
        rt_put_t(lds + RT_VT, 2 * vpr, vpc * 8, v0, v1, 0.f, 0.f, false); rt_put_t(lds + RT_VT, 2 * vpr, vpc * 8 + 64, v2, v3, 0.f, 0.f, false);
        __syncthreads();
#pragma unroll
        for (int s = 0; s < 8; ++s) tile = MFMA32(*(const LAS bf16x8*)(vtA + 32 * s), *(const LAS bf16x8*)(ktB + 32 * s), tile);
        __syncthreads();
    }
#ifndef RT_SKIP_P2
    const int qt = wave & 3, eh = wave >> 2;
    const float cf = exp2f(l2f * (float)(32 * qt + r + 1)), cb = exp2f(l2b * (float)(128 - 32 * qt - r));
#pragma unroll 1
    for (int c = 0; c < 16; ++c) {
        rt_tile_to_img(lds + RT_STF, tile, eb_s, db_s, r, h);
        {
            const bf16* kp = rk + (rowb + 128 * c + kj0) * 512 + kpc * 8; const v4u k0 = *(const v4u*)kp, k1 = *(const v4u*)(kp + 512);
            *(LAS v4u*)(lds + RT_KIMG + kj0 * RT_ROWK + kpc * 16) = k0; *(LAS v4u*)(lds + RT_KIMG + (kj0 + 1) * RT_ROWK + kpc * 16) = k1;
            rt_put_t(lds + RT_KT, kj0, kpc * 8, k0, k1, kf0, kf1, true);
            const bf16* vp = rv + (rowb + 128 * c + 2 * vpr) * 1024 + vpc * 8;
            const v4u v0 = *(const v4u*)vp, v1 = *(const v4u*)(vp + 1024), v2 = *(const v4u*)(vp + 64), v3 = *(const v4u*)(vp + 1024 + 64);
            rt_put_t(lds + RT_VT, 2 * vpr, vpc * 8, v0, v1, 0.f, 0.f, false); rt_put_t(lds + RT_VT, 2 * vpr, vpc * 8 + 64, v2, v3, 0.f, 0.f, false);
            const bf16* sp = sbg + (size_t)c * 8192;
#pragma unroll
            for (int q = 0; q < 2; ++q) { const int pcs = tid + 512 * q, row = pcs >> 3, pc = pcs & 7; *(LAS v4u*)(lds + RT_STB + row * RT_ROWK + pc * 16) = *(const v4u*)(sp + row * 64 + pc * 8); }
        }
        const size_t qrow = rowb + 128 * c + 32 * qt + r;
        bf16x8 qf[4];
#pragma unroll
        for (int ds = 0; ds < 4; ++ds) qf[ds] = *(const bf16x8*)(rq + qrow * 512 + 16 * ds + 8 * h);
        __syncthreads();
        bf16x8 pk[4][2];
#pragma unroll
        for (int kc = 0; kc < 4; ++kc) {
            f32x16 s;
#pragma unroll
            for (int i = 0; i < 16; ++i) s[i] = 0.f;
            const LAS unsigned char* kp = lds + RT_KIMG + (32 * kc + r) * RT_ROWK + 16 * h;
#pragma unroll
            for (int ds = 0; ds < 4; ++ds) s = MFMA32(*(const LAS bf16x8*)(kp + 32 * ds), qf[ds], s);
            float d0 = (float)(32 * qt + r - 32 * kc - 4 * h); asm volatile("" : "+v"(d0));
#pragma unroll
            for (int i = 0; i < 16; ++i) { const float df = d0 - (float)((i & 3) + 8 * (i >> 2)); s[i] *= __builtin_amdgcn_exp2f(fminf(l2f * df, -l2b * df) - 3.0f); }
            pk[kc][0] = pack8(s, 0); pk[kc][1] = pack8(s, 1);
            __builtin_amdgcn_sched_barrier(0);
        }
        f32x16 o[2];
#pragma unroll
        for (int e2 = 0; e2 < 2; ++e2) {
            const int eb = 2 * eh + e2;
            f32x16 acc, xf, xb;
#pragma unroll
            for (int i = 0; i < 16; ++i) { acc[i] = 0.f; xf[i] = 0.f; xb[i] = 0.f; }
            const LAS unsigned char* vp = lds + RT_VT + (32 * eb + r) * RT_ROWT + 16 * h;
#pragma unroll
            for (int kc = 0; kc < 4; ++kc) { acc = MFMA32(*(const LAS bf16x8*)(vp + 64 * kc), pk[kc][0], acc); acc = MFMA32(*(const LAS bf16x8*)(vp + 64 * kc + 32), pk[kc][1], acc); }
            const LAS unsigned char* fp = lds + RT_STF + (32 * eb + r) * RT_ROWK + 16 * h; const LAS unsigned char* bp = lds + RT_STB + (32 * eb + r) * RT_ROWK + 16 * h;
#pragma unroll
            for (int ds = 0; ds < 4; ++ds) { xf = MFMA32(*(const LAS bf16x8*)(fp + 32 * ds), qf[ds], xf); xb = MFMA32(*(const LAS bf16x8*)(bp + 32 * ds), qf[ds], xb); }
#pragma unroll
            for (int i = 0; i < 16; ++i) o[e2][i] = acc[i] + cf * xf[i] + cb * xb[i];
            __builtin_amdgcn_sched_barrier(0);
        }
        float s1 = 0.f, s2 = 0.f;
#pragma unroll
        for (int e2 = 0; e2 < 2; ++e2)
#pragma unroll
            for (int i = 0; i < 16; ++i) { s1 += o[e2][i]; s2 += o[e2][i] * o[e2][i]; }
        s1 += __shfl_xor(s1, 32); s2 += __shfl_xor(s2, 32);
        LAS float* xch = (LAS float*)(lds + RT_XCH);
        if (h == 0) { xch[(eh * 128 + 32 * qt + r) * 2] = s1; xch[(eh * 128 + 32 * qt + r) * 2 + 1] = s2; }
        __builtin_amdgcn_sched_barrier(0);
#pragma unroll
        for (int i = 0; i < 16; ++i) tile[i] *= cdf;
#pragma unroll
        for (int s = 0; s < 8; ++s) tile = MFMA32(*(const LAS bf16x8*)(vtA + 32 * s), *(const LAS bf16x8*)(ktB + 32 * s), tile);
        __syncthreads();
        {
            const float p1 = xch[((eh ^ 1) * 128 + 32 * qt + r) * 2], p2 = xch[((eh ^ 1) * 128 + 32 * qt + r) * 2 + 1];
            const float mu = (s1 + p1) * (1.0f / 128.0f), var = (s2 + p2) * (1.0f / 128.0f) - mu * mu, rstd = 1.0f / sqrtf(fmaxf(var, 0.f) + GN_EPS);
            bf16* gp = rg + qrow * 1024; bf16* op = retbase + hd * 128 + qrow * 1024; const float* gn = a.in[5] + hd * 128;
#pragma unroll
            for (int e2 = 0; e2 < 2; ++e2)
#pragma unroll
                for (int gq = 0; gq < 4; ++gq) { const int e0 = 32 * (2 * eh + e2) + 8 * gq + 4 * h; const v2u gg = *(const v2u*)(gp + e0); const f32x4 gv = *(const f32x4*)(gn + e0);
                    const float g0 = bflo(gg.x), g1 = bfhi(gg.x), g2 = bflo(gg.y), g3 = bfhi(gg.y);
                    v2u w; w.x = cvtpk(g0 * sigmoidf_(g0) * ((o[e2][4 * gq] - mu) * rstd * gv.x), g1 * sigmoidf_(g1) * ((o[e2][4 * gq + 1] - mu) * rstd * gv.y));
                    w.y = cvtpk(g2 * sigmoidf_(g2) * ((o[e2][4 * gq + 2] - mu) * rstd * gv.z), g3 * sigmoidf_(g3) * ((o[e2][4 * gq + 3] - mu) * rstd * gv.w));
                    *(v2u*)(op + e0) = w; }
        }
    }
#endif
    __syncthreads();
}

#define XB_TMO      128
#define XB_XCNT(j)  (256  + 64 * (j))
#define XB_XSUB(j)  (1280 + 64 * (j))
#define XB_XGEN(j)  (2304 + 64 * (j))
#define XB_TOP      3328
#define XB_TOPGEN   3392
#define XCD_BAR_WORDS 3456
#define XB_SPIN_CAP (1u << 18)

__device__ __forceinline__ unsigned xb_ld(unsigned* p)              { return __hip_atomic_load(p, __ATOMIC_RELAXED, __HIP_MEMORY_SCOPE_AGENT); }
__device__ __forceinline__ unsigned xb_add(unsigned* p, unsigned v) { return __hip_atomic_fetch_add(p, v, __ATOMIC_RELAXED, __HIP_MEMORY_SCOPE_AGENT); }
__device__ __forceinline__ unsigned xb_xcc_id() { return (unsigned)__builtin_amdgcn_s_getreg((3 << 11) | 20) & 0xFu; }
#define XB_SPIN(cond, bar) do { unsigned _sp = 0; while (cond) { __builtin_amdgcn_s_sleep(1); \
    if ((++_sp & 255u) == 0u) { if (xb_ld(&(bar)[XB_TMO])) break; if (_sp > XB_SPIN_CAP) { atomicAdd(&(bar)[XB_TMO], 1u); break; } } } } while (0)

struct XcdBarrier {
    unsigned* bar; unsigned x;
    volatile LAS unsigned* st;
};

__device__ __forceinline__ XcdBarrier xcd_barrier_post(unsigned* bar, volatile LAS unsigned* st) {
    XcdBarrier b; b.bar = bar; b.x = xb_xcc_id(); b.st = st;
    if (threadIdx.x == 0) (void)xb_add(&bar[XB_XCNT(b.x)], 1u);
    return b;
}
__device__ __forceinline__ void xcd_barrier_complete(unsigned* bar, unsigned x, unsigned& nloc, unsigned& nx) {
    const unsigned G = gridDim.x * gridDim.y * gridDim.z;
    unsigned sum, cnt, mine, sp = 0u;
    for (;;) {
        sum = 0u; cnt = 0u; mine = 0u;
#pragma unroll
        for (unsigned j = 0; j < 16; ++j) { const unsigned c = xb_ld(&bar[XB_XCNT(j)]); sum += c; cnt += (c > 0u) ? 1u : 0u; mine = (j == x) ? c : mine; }
        if (sum == G) break;
        __builtin_amdgcn_s_sleep(1);
        if ((++sp & 255u) == 0u) { if (xb_ld(&bar[XB_TMO])) break; if (sp > XB_SPIN_CAP) { atomicAdd(&bar[XB_TMO], 1u); break; } }
    }
    nloc = mine > 0u ? mine : 1u; nx = cnt > 0u ? cnt : 1u;
}

__device__ __forceinline__ void xcd_barrier(const XcdBarrier& b) {
    asm volatile("s_waitcnt vmcnt(0)" ::: "memory");
    __syncthreads();
    if (threadIdx.x == 0) {
        unsigned* bar = b.bar;
        __builtin_amdgcn_s_waitcnt(0);
        unsigned nloc = b.st[0], nx = b.st[1];
        if (nloc == 0u) { xcd_barrier_complete(bar, b.x, nloc, nx); b.st[0] = nloc; b.st[1] = nx; }
        const unsigned old = xb_add(&bar[XB_XSUB(b.x)], 1u);
        const unsigned gen = old / nloc;
        if (old + 1u == (gen + 1u) * nloc) {
            __builtin_amdgcn_fence(__ATOMIC_RELEASE, "agent");
            asm volatile("s_waitcnt vmcnt(0)" ::: "memory");
            const unsigned og = xb_add(&bar[XB_TOP], 1u);
            const unsigned tg = og / nx;
            if (og + 1u == (tg + 1u) * nx) xb_add(&bar[XB_TOPGEN], 1u);
            else XB_SPIN(xb_ld(&bar[XB_TOPGEN]) == tg, bar);
            __builtin_amdgcn_fence(__ATOMIC_ACQUIRE, "agent");
            xb_add(&bar[XB_XGEN(b.x)], 1u);
            asm volatile("s_waitcnt vmcnt(0)" ::: "memory");
        } else {
            XB_SPIN(xb_ld(&bar[XB_XGEN(b.x)]) == gen, bar);
            __builtin_amdgcn_fence(__ATOMIC_ACQUIRE, "agent");
            asm volatile("s_waitcnt vmcnt(0)" ::: "memory");
        }
    }
    __syncthreads();
}
constexpr int CW_QUEUE = 8192;
constexpr int MISC_OFF = 131072 + 320;
constexpr int LDS_BYTES = 147456;
#ifndef MK_N_LAUNCHES
#define MK_N_LAUNCHES 1
#endif
__global__ void __launch_bounds__(NTHR, 2) fwd_megakernel(Args a) {
    extern __shared__ __attribute__((aligned(16))) unsigned char lds_raw[];
    LAS unsigned char* lds = (LAS unsigned char*)lds_raw;
    const int tid = threadIdx.x, lane = tid & 63, wave = __builtin_amdgcn_readfirstlane(tid >> 6), G = gridDim.x;
    cg::grid_group grid = cg::this_grid();
    volatile LAS unsigned* MISC = (volatile LAS unsigned*)(lds + MISC_OFF);
    if (tid < 32) MISC[tid] = 0u;
    __syncthreads();
    XcdBarrier bar = xcd_barrier_post((unsigned*)(a.ws + WS_CTL), MISC + 8);
    unsigned char* ws = a.ws;
    const int lo = a.ph_lo, hi = a.ph_hi;
#define IN(k) (lo <= (k) && (k) < hi)
#ifdef PROBE_PHASE
    unsigned long long tsv[NPH + 1]; tsv[0] = __builtin_amdgcn_s_memrealtime();
#define SEAM(k) do { if (IN(k) && IN((k) + 1)) grid.sync(); tsv[(k) + 1] = __builtin_amdgcn_s_memrealtime(); } while (0)
#elif defined(PROBE_DUP_SYNC)
#define SEAM(k) do { if (IN(k) && IN((k) + 1)) { grid.sync(); grid.sync(); } } while (0)
#else
#define SEAM(k) do { if (IN(k) && IN((k) + 1)) xcd_barrier(bar); } while (0)
#endif
    if (hi > NPH) grid.sync();

    if (IN(0)) p0_prologue(a, lds, tid, lane, wave, G);
#ifdef PROBE_DUP_P0
    if (IN(0)) { __syncthreads(); p0_prologue(a, lds, tid, lane, wave, G); }
#endif
    SEAM(0);
    if (IN(1)) {
        pg8::Gemm g{(const pg8::bf16_t*)a.out, (const pg8::bf16_t*)(ws + WS_WIN), M, INC, 1024}; pg8::StaticOrder S; S.init(M, INC, G, (int)blockIdx.x);
        Epi1 E{ws};
        pg8::gemm_phase<Epi1, pg8::StaticOrder, true, true>(lds, g, S, E);
#ifdef PROBE_DUP_P1
        pg8::gemm_phase<Epi1, pg8::StaticOrder, true, true>(lds, g, S, E);
#endif
    }
    SEAM(1);
    if (IN(2)) {
#ifdef PROBE_DUP_RET
        for (int u = blockIdx.x; u < BATCH * RH; u += G) ret_unit(a, lds, u, tid, lane, wave, (bf16*)a.out);
#endif
        for (int u = blockIdx.x; u < BATCH * RH; u += G) ret_unit(a, lds, u, tid, lane, wave, (bf16*)(ws + WS_RG));
        unsigned* qhead = (unsigned*)(ws + WS_CTL) + CW_QUEUE;
        for (;;) {
            if (tid == 0) MISC[0] = __hip_atomic_fetch_add(qhead, 1u, __ATOMIC_RELAXED, __HIP_MEMORY_SCOPE_AGENT);
            __syncthreads();
            const int u = (int)MISC[0];
            if (u >= BATCH * AKH * 16) break;
            attn_unit(a, lds, u, tid, lane, wave, (bf16*)(ws + WS_AQ));
        }
    }
    SEAM(2);
    if (IN(3)) {
        pg8::Gemm g{(const pg8::bf16_t*)(ws + WS_RG), (const pg8::bf16_t*)(ws + WS_WBR), 2 * M, 2048, 1024}; Sched3 S; S.S.init(M, 1024, G, (int)blockIdx.x);
        Epi3 E{(const bf16*)(ws + WS_GA), (bf16*)(ws + WS_GB), a.out};
        pg8::gemm_phase<Epi3, Sched3, true, true>(lds, g, S, E);
    }
    SEAM(3);
    if (IN(4)) {
        pg8::Gemm g{(const pg8::bf16_t*)(ws + WS_GB), (const pg8::bf16_t*)(ws + WS_WO), M, 1024, 1024}; pg8::StaticOrder S; S.init(M, 1024, G, (int)blockIdx.x);
        EpiRes<true> E{a.in[0], a.out, (bf16*)(ws + WS_XB), (float*)(ws + WS_SSQ1)};
        pg8::gemm_phase<EpiRes<true>, pg8::StaticOrder, true, true>(lds, g, S, E);
#ifdef PROBE_DUP_P4
        pg8::gemm_phase<EpiRes<true>, pg8::StaticOrder, true, true>(lds, g, S, E);
#endif
    }
    SEAM(4);
    if (IN(5)) {
        pg8::Gemm g{(const pg8::bf16_t*)(ws + WS_XB), (const pg8::bf16_t*)(ws + WS_WGU), M, 2 * DFF, 1024}; pg8::StaticOrder S; S.init(M, 2 * DFF, G, (int)blockIdx.x);
        Epi5 E{(bf16*)(ws + WS_ACT), (const float*)(ws + WS_SSQ1)};
        pg8::gemm_phase<Epi5, pg8::StaticOrder, true, true>(lds, g, S, E);
#ifdef PROBE_DUP_P5
        pg8::gemm_phase<Epi5, pg8::StaticOrder, true, true>(lds, g, S, E);
#endif
    }
    SEAM(5);
    if (IN(6)) {
        pg8::Gemm g{(const pg8::bf16_t*)(ws + WS_ACT), (const pg8::bf16_t*)(ws + WS_WD), M, 1024, DFF}; pg8::StaticOrder S; S.init(M, 1024, G, (int)blockIdx.x);
        EpiRes<false> E{a.out, a.out, nullptr, (float*)(ws + WS_SSQ2)};
        pg8::gemm_phase<EpiRes<false>, pg8::StaticOrder, true, true>(lds, g, S, E);
    }
    SEAM(6);
    if (IN(7)) {
        const int gw = blockIdx.x * NWAVES + wave, NGW = G * NWAVES;
        const f32x4* gp = (const f32x4*)a.in[14] + lane; f32x4 g[4];
#pragma unroll
        for (int j = 0; j < 4; ++j) g[j] = gp[64 * j];
        const float* ssq = (const float*)(ws + WS_SSQ2);
        for (int m = gw; m < M; m += NGW) {
            const f32x4* sp = (const f32x4*)(ssq + (size_t)m * 16); const f32x4 s0 = sp[0], s1 = sp[1], s2 = sp[2], s3 = sp[3];
            const float tot = ((s0[0] + s0[1]) + (s0[2] + s0[3])) + ((s1[0] + s1[1]) + (s1[2] + s1[3])) + ((s2[0] + s2[1]) + (s2[2] + s2[3])) + ((s3[0] + s3[1]) + (s3[2] + s3[3]));
            const float rstd = 1.0f / sqrtf(tot * (1.0f / DM) + RMS_EPS);
            f32x4* xr = (f32x4*)(a.out + (size_t)m * DM) + lane;
#pragma unroll
            for (int j = 0; j < 4; ++j) { f32x4 v = xr[64 * j]; v.x *= rstd * g[j].x; v.y *= rstd * g[j].y; v.z *= rstd * g[j].z; v.w *= rstd * g[j].w; xr[64 * j] = v; }
        }
    }
#ifdef PROBE_PHASE
    tsv[NPH] = __builtin_amdgcn_s_memrealtime();
    if (blockIdx.x == 0 && tid == 0) { asm volatile("s_waitcnt vmcnt(0)" ::: "memory"); a.out[0] = (float)(tsv[PROBE_PHASE + 1] - tsv[PROBE_PHASE]) * 0.01f; }
#endif
#undef IN
#undef SEAM
}

extern "C" void kernel_launch(void* const* d_in, const int* in_sizes, int n_in, void* d_out, int out_size, void* d_ws, size_t ws_size, hipStream_t stream) {
    static int grid = 0;
    if (grid == 0) {
        if (n_in != 15 || out_size != M * DM || ws_size < (size_t)496 * MiB) { fprintf(stderr, "kernel_launch: unexpected shapes: n_in %d out %d ws %zu\n", n_in, out_size, ws_size); grid = -1; return; }
        int dev = 0, cus = 0, per_cu = 0;
        (void)hipGetDevice(&dev); (void)hipDeviceGetAttribute(&cus, hipDeviceAttributeMultiprocessorCount, dev);
        if (hipFuncSetAttribute((const void*)fwd_megakernel, hipFuncAttributeMaxDynamicSharedMemorySize, LDS_BYTES) != hipSuccess) { fprintf(stderr, "kernel_launch: hipFuncSetAttribute failed\n"); grid = -1; return; }
        if (hipOccupancyMaxActiveBlocksPerMultiprocessor(&per_cu, (const void*)fwd_megakernel, NTHR, LDS_BYTES) != hipSuccess || per_cu < 1) { fprintf(stderr, "kernel_launch: occupancy query says %d\n", per_cu); per_cu = 1; }
        (void)hipGetLastError();
        grid = cus * 1;
        if (grid <= 0) grid = 256;
    }
    if (grid < 0) return;
    (void)hipMemsetAsync((char*)d_ws + WS_CTL, 0, CTL_ZERO_BYTES, stream);
    Args a{};
    for (int i = 0; i < 15; ++i) a.in[i] = (const float*)d_in[i];
    a.out = (float*)d_out; a.ws = (unsigned char*)d_ws;
#if MK_N_LAUNCHES == 1
    a.ph_lo = 0; a.ph_hi = NPH;
    void* kargs[] = {&a};
    hipError_t e = hipLaunchCooperativeKernel((const void*)fwd_megakernel, dim3(grid), dim3(NTHR), kargs, LDS_BYTES, stream);
    if (e != hipSuccess) fprintf(stderr, "cooperative launch failed: %s (grid %d)\n", hipGetErrorString(e), grid);
#else
    for (int p = 0; p < NPH; ++p) { a.ph_lo = p; a.ph_hi = p + 1; hipLaunchKernelGGL(fwd_megakernel, dim3(grid), dim3(NTHR), LDS_BYTES, stream, a); }
#endif
}
```

```cpp
#include <hip/hip_runtime.h>
#include <hip/hip_cooperative_groups.h>
#include <cstdio>
#include <cstdint>
namespace cg = cooperative_groups;
namespace pg8 {
#define PG8_LAS __attribute__((address_space(3)))
typedef unsigned short bf16_t;
typedef short bf16x8 __attribute__((ext_vector_type(8)));
typedef float f32x4 __attribute__((ext_vector_type(4)));
typedef unsigned u32x4 __attribute__((ext_vector_type(4)));
constexpr int BM = 256, BK = 64, HALF = 128, HTB = HALF * BK * 2  , STAGE_BYTES = 8 * HTB, NXCD = 8, WGM = 8;

__host__ __device__ __forceinline__ int lds_byte(int r, int c) { const int st = (r >> 4) * 2 + (c >> 5), rr = r & 15, cc = c & 31, ob = rr * 64 + cc * 2; return st * 1024 + (ob ^ (((ob >> 9) & 1) << 5)); }
__host__ __device__ __forceinline__ void stage_rc(int b, int& R, int& C) { const int st = b / 1024, sb = b % 1024, swz = sb ^ (((sb >> 9) & 1) << 5); R = (st >> 1) * 16 + swz / 64; C = (st & 1) * 32 + (swz % 64) / 2; }
__host__ __device__ __forceinline__ int perm32(int rho) { const int n = rho >> 4, i = rho & 15; return 8 * (i >> 2) + 4 * n + (i & 3); }

struct Unit { int pm, pn; };
struct Gemm { const bf16_t* A; const bf16_t* Bt; int M, N, K; };

struct StaticOrder {
    int nM, nN, nwg, G, c;
    __host__ __device__ void init(int M, int N, int G_, int c_) { nM = M / BM; nN = N / BM; nwg = nM * nN; G = G_; c = c_; }
    __host__ __device__ bool next(int i, Unit& u) const {
        const long L = (long)i * G + c; if (L >= nwg) return false;
        int wgid = (int)L; { const int q = nwg / NXCD, r = nwg % NXCD, xcd = wgid % NXCD, off = wgid / NXCD; wgid = (xcd < r ? xcd * (q + 1) : r * (q + 1) + (xcd - r) * q) + off; }
        const int nig = WGM * nN, gid = wgid / nig, fm = gid * WGM, gsz = (nM - fm) < WGM ? (nM - fm) : WGM;
        u.pm = fm + ((wgid % nig) % gsz); u.pn = (wgid % nig) / gsz; return true;
    }
    __device__ __forceinline__ void a_ready(const Unit&) const {}
    __device__ __forceinline__ void done(const Unit&) const {}
};

__device__ __forceinline__ unsigned cvt_pk_bf16(float lo, float hi) { unsigned r; asm volatile("v_cvt_pk_bf16_f32 %0, %1, %2" : "=v"(r) : "v"(lo), "v"(hi)); return r; }
typedef float f32x2 __attribute__((ext_vector_type(2)));
template <class Epi, class Sched, bool ALIGN_EPI = false, bool SP2 = false>
__device__ __forceinline__ void gemm_phase(PG8_LAS unsigned char* lds, const Gemm g, const Sched& S, const Epi& E) {
    const int tid = threadIdx.x, wid = __builtin_amdgcn_readfirstlane(tid >> 6), lane = tid & 63, wr = wid >> 2, wc = wid & 3, fr = lane & 15, fq = lane >> 4;
    const int K = g.K, nt = K / BK;
    unsigned voffA[2], voffB[2];
#pragma unroll
    for (int i = 0; i < 2; ++i) { int R, C; stage_rc(tid * 16 + i * 8192, R, C); const int Rb = Epi::PERM ? ((R & ~31) + perm32(R & 31)) : R;
        voffA[i] = (unsigned)(R * K + C) * 2u; voffB[i] = (unsigned)(Rb * K + C) * 2u; }
    const size_t kstep = (size_t)(BK * 2);
    const size_t hstep = (size_t)HALF * K * 2;
    const size_t tstep = 2 * hstep;
    const unsigned ldsw = (unsigned)wid * 1024u;
    const int aoff = lds_byte(wr * 64 + fr, fq * 8), boff = lds_byte(wc * 32 + fr, fq * 8);
#define PG8_SA(b, h) (((b) * 2 + (h)) * HTB)
#define PG8_SB(b, h) ((4 + (b) * 2 + (h)) * HTB)
#define PG8_STAGE(bufoff, gbase, voff) do { _Pragma("unroll") for (int _i = 0; _i < 2; ++_i) \
        __builtin_amdgcn_global_load_lds((const unsigned*)((const char*)(gbase) + (voff)[_i]), (PG8_LAS unsigned*)(lds + (bufoff) + ldsw + _i * 8192), 16, 0, 0); } while (0)
#define PG8_LDA(dst, b, h) do { _Pragma("unroll") for (int m = 0; m < 4; ++m) _Pragma("unroll") for (int k = 0; k < 2; ++k) dst[m][k] = *(const PG8_LAS bf16x8*)(lds + PG8_SA(b, h) + aoff + m * 2048 + k * 1024); } while (0)
#define PG8_LDB(dst, b, h) do { _Pragma("unroll") for (int n = 0; n < 2; ++n) _Pragma("unroll") for (int k = 0; k < 2; ++k) dst[n][k] = *(const PG8_LAS bf16x8*)(lds + PG8_SB(b, h) + boff + n * 2048 + k * 1024); } while (0)
#define PG8_MMA(ai, bj, At, Bt) do { __builtin_amdgcn_s_setprio(1); _Pragma("unroll") for (int m = 0; m < 4; ++m) _Pragma("unroll") for (int n = 0; n < 2; ++n) _Pragma("unroll") for (int k = 0; k < 2; ++k) \
        acc[ai][bj][m][n] = __builtin_amdgcn_mfma_f32_16x16x32_bf16(Bt[n][k], At[m][k], acc[ai][bj][m][n], 0, 0, 0); __builtin_amdgcn_s_setprio(0); } while (0)
#define PG8_WAIT_V(n) asm volatile("s_waitcnt vmcnt(" #n ")" ::: "memory")
#define PG8_WAIT_L(n) asm volatile("s_waitcnt lgkmcnt(" #n ")" ::: "memory")
#define PG8_BAR __builtin_amdgcn_s_barrier()
#define PG8_SCHED __builtin_amdgcn_sched_barrier(0)
    Unit cur, nxt; int ui = 0;
    if (!S.next(0, cur)) return;
    f32x4 acc[2][2][4][2];
#pragma unroll
    for (int a = 0; a < 2; ++a)
#pragma unroll
        for (int b = 0; b < 2; ++b)
#pragma unroll
            for (int m = 0; m < 4; ++m)
#pragma unroll
                for (int n = 0; n < 2; ++n) acc[a][b][m][n] = (f32x4){0.f, 0.f, 0.f, 0.f};
    bf16x8 At[4][2], B0[2][2], B1[2][2];
    const char* cA = (const char*)g.A + (size_t)cur.pm * tstep; const char* cB = (const char*)g.Bt + (size_t)cur.pn * tstep;
    S.a_ready(cur);
    if constexpr (SP2) {
        PG8_STAGE(PG8_SB(0, 0), cB, voffB); PG8_STAGE(PG8_SB(0, 1), cB + hstep, voffB); PG8_STAGE(PG8_SA(0, 0), cA, voffA); PG8_STAGE(PG8_SA(0, 1), cA + hstep, voffA);
        if (wr == 1) PG8_BAR;
        PG8_WAIT_V(2); PG8_BAR;
        PG8_STAGE(PG8_SB(1, 0), cB + kstep, voffB); PG8_STAGE(PG8_SA(1, 0), cA + kstep, voffA); PG8_STAGE(PG8_SB(1, 1), cB + hstep + kstep, voffB);
        PG8_WAIT_V(6); PG8_BAR;
    } else {
        PG8_STAGE(PG8_SB(0, 0), cB, voffB); PG8_STAGE(PG8_SA(0, 0), cA, voffA); PG8_STAGE(PG8_SB(0, 1), cB + hstep, voffB); PG8_STAGE(PG8_SA(0, 1), cA + hstep, voffA);
        if (wr == 1) PG8_BAR;
        PG8_WAIT_V(4); PG8_BAR;
        PG8_STAGE(PG8_SB(1, 0), cB + kstep, voffB); PG8_STAGE(PG8_SA(1, 0), cA + kstep, voffA); PG8_STAGE(PG8_SB(1, 1), cB + hstep + kstep, voffB);
        PG8_WAIT_V(6); PG8_BAR;
    }
    for (;;) {
        const bool has_next = S.next(ui + 1, nxt);
        const char* nA = has_next ? (const char*)g.A + (size_t)nxt.pm * tstep : cA; const char* nB = has_next ? (const char*)g.Bt + (size_t)nxt.pn * tstep : cB;
        for (int t = 0; t < nt; t += 2) {
            const bool last = (t == nt - 2);
            const char* a1 = cA + (size_t)(t + 1) * kstep;
            const char* a2 = last ? nA : cA + (size_t)(t + 2) * kstep; const char* b2 = last ? nB : cB + (size_t)(t + 2) * kstep;
            const char* a3 = a2 + kstep; const char* b3 = b2 + kstep;
            if (last && has_next) S.a_ready(nxt);
            if constexpr (SP2) {
            PG8_LDB(B0, 0, 0); PG8_LDB(B1, 0, 1); PG8_SCHED; PG8_LDA(At, 0, 0); PG8_STAGE(PG8_SA(1, 1), a1 + hstep, voffA);
            PG8_WAIT_V(8); PG8_WAIT_L(0); PG8_BAR; PG8_MMA(0, 0, At, B0); PG8_MMA(0, 1, At, B1); PG8_BAR; PG8_SCHED;
            PG8_LDA(At, 0, 1); PG8_STAGE(PG8_SB(0, 0), b2, voffB); PG8_STAGE(PG8_SB(0, 1), b2 + hstep, voffB); PG8_STAGE(PG8_SA(0, 0), a2, voffA);
            PG8_WAIT_V(8); PG8_WAIT_L(0); PG8_BAR; PG8_MMA(1, 0, At, B0); PG8_MMA(1, 1, At, B1); PG8_BAR; PG8_SCHED;
            PG8_LDB(B0, 1, 0); PG8_LDB(B1, 1, 1); PG8_SCHED; PG8_LDA(At, 1, 0); PG8_STAGE(PG8_SA(0, 1), a2 + hstep, voffA);
            PG8_WAIT_V(8); PG8_WAIT_L(0); PG8_BAR; PG8_MMA(0, 0, At, B0); PG8_MMA(0, 1, At, B1); PG8_BAR; PG8_SCHED;
            PG8_LDA(At, 1, 1); PG8_STAGE(PG8_SB(1, 0), b3, voffB); PG8_STAGE(PG8_SB(1, 1), b3 + hstep, voffB); PG8_STAGE(PG8_SA(1, 0), a3, voffA);
            PG8_WAIT_V(8); PG8_WAIT_L(0); PG8_BAR; PG8_MMA(1, 0, At, B0); PG8_MMA(1, 1, At, B1); PG8_BAR; PG8_SCHED;
            } else {
            PG8_LDB(B0, 0, 0); PG8_SCHED; PG8_LDA(At, 0, 0); PG8_STAGE(PG8_SA(1, 1), a1 + hstep, voffA);
            PG8_WAIT_L(8); PG8_BAR; PG8_WAIT_L(0); PG8_MMA(0, 0, At, B0); PG8_BAR; PG8_SCHED;
            PG8_LDB(B1, 0, 1); PG8_STAGE(PG8_SB(0, 0), b2, voffB);
            PG8_BAR; PG8_WAIT_L(0); PG8_MMA(0, 1, At, B1); PG8_BAR;
            PG8_LDA(At, 0, 1); PG8_STAGE(PG8_SA(0, 0), a2, voffA);
            PG8_BAR; PG8_WAIT_L(0); PG8_MMA(1, 0, At, B0); PG8_BAR; PG8_SCHED;
            PG8_STAGE(PG8_SB(0, 1), b2 + hstep, voffB);
            PG8_WAIT_V(6); PG8_BAR; PG8_MMA(1, 1, At, B1); PG8_BAR;
            PG8_LDB(B0, 1, 0); PG8_SCHED; PG8_LDA(At, 1, 0); PG8_STAGE(PG8_SA(0, 1), a2 + hstep, voffA);
            PG8_WAIT_L(8); PG8_BAR; PG8_WAIT_L(0); PG8_MMA(0, 0, At, B0); PG8_BAR; PG8_SCHED;
            PG8_LDB(B1, 1, 1); PG8_STAGE(PG8_SB(1, 0), b3, voffB);
            PG8_BAR; PG8_WAIT_L(0); PG8_MMA(0, 1, At, B1); PG8_BAR;
            PG8_LDA(At, 1, 1); PG8_STAGE(PG8_SA(1, 0), a3, voffA);
            PG8_BAR; PG8_WAIT_L(0); PG8_MMA(1, 0, At, B0); PG8_BAR; PG8_SCHED;
            PG8_STAGE(PG8_SB(1, 1), b3 + hstep, voffB);
            PG8_WAIT_V(6); PG8_BAR; PG8_MMA(1, 1, At, B1); PG8_BAR;
            }
        }
        if constexpr (ALIGN_EPI) { if (wr == 0) PG8_BAR; }
        bool keep_acc = false;
        if constexpr (!Epi::AFTER_DRAIN) { if constexpr (Epi::CHAIN) keep_acc = E.chain(acc, cur, wr, wc, fr, fq); else E(acc, cur, wr, wc, fr, fq); S.done(cur); }
        if (!has_next) break;
        if (!keep_acc) {
#pragma unroll
        for (int a = 0; a < 2; ++a)
#pragma unroll
            for (int b = 0; b < 2; ++b)
#pragma unroll
                for (int m = 0; m < 4; ++m)
#pragma unroll
                    for (int n = 0; n < 2; ++n) acc[a][b][m][n] = (f32x4){0.f, 0.f, 0.f, 0.f};
        }
        cur = nxt; cA = nA; cB = nB; ++ui;
        if constexpr (ALIGN_EPI) { if (wr == 1) PG8_BAR; }
    }
    PG8_WAIT_V(0);
    if constexpr (!ALIGN_EPI) { if (wr == 0) PG8_BAR; }
    PG8_BAR;
    if constexpr (Epi::AFTER_DRAIN) { E.fused(acc, cur, wr, wc, fr, fq, lds, wid, lane); S.done(cur); }
#undef PG8_SA
#undef PG8_SB
#undef PG8_STAGE
#undef PG8_LDA
#undef PG8_LDB
#undef PG8_MMA
#undef PG8_WAIT_V
#undef PG8_WAIT_L
#undef PG8_BAR
#undef PG8_SCHED
}
}

constexpr int NWAVES = 8, NTHR = 512;
constexpr int BATCH = 16, SEQ = 2048, DM = 1024, NMETA = 16;
constexpr int M = BATCH * SEQ;
constexpr int RH = 8, RDK = 64, RDV = 128;
constexpr int AQH = 16, AKH = 4, ADH = 64;
constexpr int DFF = 2816, INC = 6656;
constexpr float RMS_EPS = 1e-6f, GN_EPS = 1e-5f;
constexpr int NPH = 8;

#define GAS __attribute__((address_space(1)))
#define LAS __attribute__((address_space(3)))
typedef unsigned short bf16;
typedef unsigned v4u __attribute__((ext_vector_type(4)));
typedef unsigned v2u __attribute__((ext_vector_type(2)));
typedef float f32x4 __attribute__((ext_vector_type(4)));
typedef short bf16x8 __attribute__((ext_vector_type(8)));

constexpr size_t MiB = 1u << 20;
constexpr size_t WS_CTL = 0, CTL_ZERO_BYTES = 64 * 1024;
constexpr size_t WS_MKR = 1 * MiB;
constexpr size_t WS_MVR = WS_MKR + 16 * 512 * 2;
constexpr size_t WS_MKA = WS_MVR + 16 * 1024 * 2;
constexpr size_t WS_MVA = WS_MKA + 16 * 256 * 2;
constexpr size_t WS_SSQ1 = 2 * MiB, WS_SSQ2 = 4 * MiB;
constexpr size_t WS_WIN = 6 * MiB, WS_WBR = 19 * MiB, WS_WO = 23 * MiB, WS_WGU = 25 * MiB, WS_WD = 36 * MiB;
constexpr size_t WS_RQ = 48 * MiB, WS_RK = 80 * MiB, WS_RV = 112 * MiB, WS_RG = 176 * MiB, WS_AQ = 240 * MiB, WS_AK = 304 * MiB, WS_AV = 320 * MiB, WS_GA = 336 * MiB, WS_GB = 400 * MiB, WS_END = 464 * MiB;
constexpr size_t WS_XB = WS_RQ;
constexpr size_t WS_ACT = WS_RV;
static_assert(WS_ACT + (size_t)M * DFF * 2 <= WS_AK, "act overlay");

__device__ __forceinline__ unsigned f2bf(float f) { unsigned u = __builtin_bit_cast(unsigned, f); return (u + 0x7fffu + ((u >> 16) & 1u)) >> 16; }
__device__ __forceinline__ unsigned pk2(float lo, float hi) { return f2bf(lo) | (f2bf(hi) << 16); }
__device__ __forceinline__ float bf2f(unsigned short h) { return __builtin_bit_cast(float, (unsigned)h << 16); }
__device__ __forceinline__ float bflo(unsigned w) { return __builtin_bit_cast(float, w << 16); }
__device__ __forceinline__ float bfhi(unsigned w) { return __builtin_bit_cast(float, w & 0xffff0000u); }
__device__ __forceinline__ float wave_sum(float v) {
#pragma unroll
    for (int o = 1; o < 64; o <<= 1) v += __shfl_xor(v, o);
    return v;
}
__device__ __forceinline__ float sigmoidf_(float x) { return 1.0f / (1.0f + __expf(-x)); }

struct Args { const float* in[15]; float* out; unsigned char* ws; int ph_lo, ph_hi; };

struct Epi1 {
    static constexpr bool PERM = true, AFTER_DRAIN = false, CHAIN = false;
    unsigned char* ws;
    __device__ __forceinline__ void operator()(const pg8::f32x4 (&acc)[2][2][4][2], const pg8::Unit& u, int wr, int wc, int fr, int fq) const {
        const int pn = u.pn; size_t off; int ldc, ct;
        if (pn < 2) { off = WS_RQ; ldc = 512; ct = pn; } else if (pn < 4) { off = WS_RK; ldc = 512; ct = pn - 2; } else if (pn < 8) { off = WS_RV; ldc = 1024; ct = pn - 4; }
        else if (pn < 12) { off = WS_RG; ldc = 1024; ct = pn - 8; } else if (pn < 16) { off = WS_AQ; ldc = 1024; ct = pn - 12; } else if (pn == 16) { off = WS_AK; ldc = 256; ct = 0; }
        else if (pn == 17) { off = WS_AV; ldc = 256; ct = 0; } else if (pn < 22) { off = WS_GA; ldc = 1024; ct = pn - 18; } else { off = WS_GB; ldc = 1024; ct = pn - 22; }
        bf16* base = (bf16*)(ws + off);
        const int row0 = u.pm * 256 + wr * 64 + fr, col0 = ct * 256 + wc * 32 + 8 * fq;
#pragma unroll
        for (int ai = 0; ai < 2; ++ai)
#pragma unroll
            for (int m = 0; m < 4; ++m) { bf16* rowp = base + (size_t)(row0 + ai * 128 + m * 16) * ldc + col0;
#pragma unroll
                for (int bj = 0; bj < 2; ++bj) { const pg8::f32x4 v0 = acc[ai][bj][m][0], v1 = acc[ai][bj][m][1]; v4u w;
                    w.x = pg8::cvt_pk_bf16(v0[0], v0[1]); w.y = pg8::cvt_pk_bf16(v0[2], v0[3]); w.z = pg8::cvt_pk_bf16(v1[0], v1[1]); w.w = pg8::cvt_pk_bf16(v1[2], v1[3]);
                    *(v4u*)(rowp + bj * 128) = w; } }
    }
};
struct Epi3 {
    static constexpr bool PERM = true, AFTER_DRAIN = false, CHAIN = true;
    const bf16* ga; const bf16* gb; bf16* merged;
    __device__ __forceinline__ bool chain(pg8::f32x4 (&acc)[2][2][4][2], const pg8::Unit& u, int wr, int wc, int fr, int fq) const {
        const bool second = u.pm >= 128; const int pm = u.pm & 127, pn = u.pn & 3;
        const int row0 = pm * 256 + wr * 64 + fr, col0 = pn * 256 + wc * 32 + 8 * fq;
#pragma unroll
        for (int ai = 0; ai < 2; ++ai)
#pragma unroll
            for (int m = 0; m < 4; ++m) { const size_t ro = (size_t)(row0 + ai * 128 + m * 16) * 1024 + col0;
#pragma unroll
                for (int bj = 0; bj < 2; ++bj) { const size_t o = ro + bj * 128;
                    const v4u gbv = *(const v4u*)(gb + o);
                    const float eb[8] = {__expf(-bflo(gbv.x)), __expf(-bfhi(gbv.x)), __expf(-bflo(gbv.y)), __expf(-bfhi(gbv.y)), __expf(-bflo(gbv.z)), __expf(-bfhi(gbv.z)), __expf(-bflo(gbv.w)), __expf(-bfhi(gbv.w))};
                    if (!second) {
                        const v4u gav = *(const v4u*)(ga + o);
                        const float ea[8] = {__expf(-bflo(gav.x)), __expf(-bfhi(gav.x)), __expf(-bflo(gav.y)), __expf(-bfhi(gav.y)), __expf(-bflo(gav.z)), __expf(-bfhi(gav.z)), __expf(-bflo(gav.w)), __expf(-bfhi(gav.w))};
#pragma unroll
                        for (int j = 0; j < 4; ++j) { acc[ai][bj][m][0][j] *= (1.0f + eb[j]) / (1.0f + ea[j]); acc[ai][bj][m][1][j] *= (1.0f + eb[4 + j]) / (1.0f + ea[4 + j]); }
                    } else {
                        float v[8];
#pragma unroll
                        for (int j = 0; j < 4; ++j) { v[j] = acc[ai][bj][m][0][j] / (1.0f + eb[j]); v[4 + j] = acc[ai][bj][m][1][j] / (1.0f + eb[4 + j]); }
                        v4u w; w.x = pg8::cvt_pk_bf16(v[0], v[1]); w.y = pg8::cvt_pk_bf16(v[2], v[3]); w.z = pg8::cvt_pk_bf16(v[4], v[5]); w.w = pg8::cvt_pk_bf16(v[6], v[7]);
                        *(v4u*)(merged + o) = w;
                    } } }
        return !second;
    }
};
struct Sched3 {
    pg8::StaticOrder S;
    __device__ bool next(int i, pg8::Unit& u) const { if (!S.next(i >> 1, u)) return false; if (i & 1) { u.pm += 128; u.pn += 4; } return true; }
    __device__ __forceinline__ void a_ready(const pg8::Unit&) const {}
    __device__ __forceinline__ void done(const pg8::Unit&) const {}
};
template <bool FIRST> struct EpiRes {
    static constexpr bool PERM = true, AFTER_DRAIN = false, CHAIN = false;
    const float* base; float* out; bf16* xb; float* ssq;
    __device__ __forceinline__ void operator()(const pg8::f32x4 (&acc)[2][2][4][2], const pg8::Unit& u, int wr, int wc, int fr, int fq) const {
        const int row0 = u.pm * 256 + wr * 64 + fr, col0 = u.pn * 256 + wc * 32 + 8 * fq;
#pragma unroll
        for (int ai = 0; ai < 2; ++ai)
#pragma unroll
            for (int m = 0; m < 4; ++m) { const int r = row0 + ai * 128 + m * 16; const size_t ro = (size_t)r * 1024 + col0; float ss = 0.f;
#pragma unroll
                for (int bj = 0; bj < 2; ++bj) { const size_t o = ro + bj * 128;
                    pg8::f32x4 v0 = *(const pg8::f32x4*)(base + o) + acc[ai][bj][m][0], v1 = *(const pg8::f32x4*)(base + o + 4) + acc[ai][bj][m][1];
                    *(pg8::f32x4*)(out + o) = v0; *(pg8::f32x4*)(out + o + 4) = v1;
                    ss += (v0[0] * v0[0] + v0[1] * v0[1]) + (v0[2] * v0[2] + v0[3] * v0[3]) + (v1[0] * v1[0] + v1[1] * v1[1]) + (v1[2] * v1[2] + v1[3] * v1[3]);
                    if (FIRST) { v4u w; w.x = pg8::cvt_pk_bf16(v0[0], v0[1]); w.y = pg8::cvt_pk_bf16(v0[2], v0[3]); w.z = pg8::cvt_pk_bf16(v1[0], v1[1]); w.w = pg8::cvt_pk_bf16(v1[2], v1[3]); *(v4u*)(xb + o) = w; } }
                ss += __shfl_xor(ss, 16); ss += __shfl_xor(ss, 32);
                if (fq == 0) ssq[(size_t)r * 16 + u.pn * 4 + wc] = ss; }
    }
};
struct Epi5 {
    static constexpr bool PERM = true, AFTER_DRAIN = false, CHAIN = false;
    bf16* act; const float* ssq;
    __device__ __forceinline__ void operator()(const pg8::f32x4 (&acc)[2][2][4][2], const pg8::Unit& u, int wr, int wc, int fr, int fq) const {
        const int row0 = u.pm * 256 + wr * 64 + fr, ch0 = u.pn * 128 + wc * 32 + 8 * fq;
#pragma unroll
        for (int ai = 0; ai < 2; ++ai)
#pragma unroll
            for (int m = 0; m < 4; ++m) { const int r = row0 + ai * 128 + m * 16;
                const pg8::f32x4* sp = (const pg8::f32x4*)(ssq + (size_t)r * 16); const pg8::f32x4 s0 = sp[0], s1 = sp[1], s2 = sp[2], s3 = sp[3];
                const float tot = ((s0[0] + s0[1]) + (s0[2] + s0[3])) + ((s1[0] + s1[1]) + (s1[2] + s1[3])) + ((s2[0] + s2[1]) + (s2[2] + s2[3])) + ((s3[0] + s3[1]) + (s3[2] + s3[3]));
                const float rstd = 1.0f / sqrtf(tot * (1.0f / 1024.0f) + RMS_EPS);
                float o[8];
#pragma unroll
                for (int n = 0; n < 2; ++n)
#pragma unroll
                    for (int j = 0; j < 4; ++j) { const float a = acc[ai][0][m][n][j] * rstd, b = acc[ai][1][m][n][j] * rstd; o[n * 4 + j] = a * sigmoidf_(a) * b; }
                v4u w; w.x = pg8::cvt_pk_bf16(o[0], o[1]); w.y = pg8::cvt_pk_bf16(o[2], o[3]); w.z = pg8::cvt_pk_bf16(o[4], o[5]); w.w = pg8::cvt_pk_bf16(o[6], o[7]);
                *(v4u*)(act + (size_t)r * DFF + ch0) = w; }
    }
};

__device__ __forceinline__ void p0_transpose_item(const float* W, int K, int N, bf16* WT, int k0, int n0, int drow0, const float* gk, LAS float* scr, int lane) {
#pragma unroll 8
    for (int i = 0; i < 32; ++i) { const int kk = 2 * i + (lane >> 5); float v = W[(size_t)(k0 + kk) * N + n0 + (lane & 31)]; if (gk) v *= gk[k0 + kk]; scr[kk * 33 + (lane & 31)] = v; }
    asm volatile("s_waitcnt lgkmcnt(0)" ::: "memory");
    const int c = lane & 7;
#pragma unroll
    for (int j = 0; j < 4; ++j) { const int n = (lane >> 3) + 8 * j; const LAS float* s = scr + (8 * c) * 33 + n;
        v4u o; o.x = pk2(s[0 * 33], s[1 * 33]); o.y = pk2(s[2 * 33], s[3 * 33]); o.z = pk2(s[4 * 33], s[5 * 33]); o.w = pk2(s[6 * 33], s[7 * 33]);
        *(v4u*)(WT + (size_t)(drow0 + n) * K + k0 + 8 * c) = o; }
    asm volatile("s_waitcnt lgkmcnt(0)" ::: "memory");
}
__device__ __forceinline__ void p0_prologue(const Args& a, LAS unsigned char* lds, int tid, int lane, int wave, int G) {
    unsigned char* ws = a.ws;
    LAS float* scr = (LAS float*)(lds + wave * 16384);
    const int gw = blockIdx.x * NWAVES + wave, NGW = G * NWAVES;
    constexpr int I_IN = 16 * 208, I_BR = 16 * 32, I_O = 16 * 32, I_GU = 16 * 176, I_D = 44 * 32;
    constexpr int NITEMS = I_IN + 2 * I_BR + I_O + I_GU + I_D;
    for (int it = gw; it < NITEMS; it += NGW) {
        int r = it;
        if (r < I_IN) { const int kb = r / 208, nb = r % 208; p0_transpose_item(a.in[2], 1024, INC, (bf16*)(ws + WS_WIN), 64 * kb, 32 * nb, 32 * nb, nullptr, scr, lane); continue; } r -= I_IN;
        if (r < I_BR) { const int kb = r / 32, nb = r % 32; p0_transpose_item(a.in[7], 1024, 1024, (bf16*)(ws + WS_WBR), 64 * kb, 32 * nb, 32 * nb, nullptr, scr, lane); continue; } r -= I_BR;
        if (r < I_BR) { const int kb = r / 32, nb = r % 32; p0_transpose_item(a.in[8], 1024, 1024, (bf16*)(ws + WS_WBR), 64 * kb, 32 * nb, 1024 + 32 * nb, nullptr, scr, lane); continue; } r -= I_BR;
        if (r < I_O) { const int kb = r / 32, nb = r % 32; p0_transpose_item(a.in[9], 1024, 1024, (bf16*)(ws + WS_WO), 64 * kb, 32 * nb, 32 * nb, nullptr, scr, lane); continue; } r -= I_O;
        if (r < I_GU) { const int kb = r / 176, nb = r % 176; const int n0 = 32 * nb, which = n0 / DFF, ch = n0 % DFF;
            p0_transpose_item(a.in[12], 1024, 2 * DFF, (bf16*)(ws + WS_WGU), 64 * kb, n0, (ch / 128) * 256 + which * 128 + (ch % 128), a.in[11], scr, lane); continue; } r -= I_GU;
        { const int kb = r / 32, nb = r % 32; p0_transpose_item(a.in[13], DFF, 1024, (bf16*)(ws + WS_WD), 64 * kb, 32 * nb, 32 * nb, nullptr, scr, lane); }
    }
    {
        const f32x4* gp = (const f32x4*)a.in[10] + lane; f32x4 g[4];
#pragma unroll
        for (int j = 0; j < 4; ++j) g[j] = gp[64 * j];
        bf16* hb = (bf16*)a.out;
        for (int m = gw; m < M; m += NGW) {
            const f32x4* xr = (const f32x4*)(a.in[0] + (size_t)m * DM) + lane; f32x4 v[4]; float s = 0.f;
#pragma unroll
            for (int j = 0; j < 4; ++j) { v[j] = xr[64 * j]; s += (v[j].x * v[j].x + v[j].y * v[j].y) + (v[j].z * v[j].z + v[j].w * v[j].w); }
            const float rstd = 1.0f / sqrtf(wave_sum(s) * (1.0f / DM) + RMS_EPS);
            v2u* o8 = (v2u*)(hb + (size_t)m * DM) + lane;
#pragma unroll
            for (int j = 0; j < 4; ++j) { v2u o; o.x = pk2(v[j].x * rstd * g[j].x, v[j].y * rstd * g[j].y); o.y = pk2(v[j].z * rstd * g[j].z, v[j].w * rstd * g[j].w); o8[64 * j] = o; }
        }
    }
    if (blockIdx.x < 64) {
        __syncthreads();
        LAS float* hm = (LAS float*)lds;
        LAS float* red = (LAS float*)(lds + 65536);
        {
            const f32x4* gp = (const f32x4*)a.in[10] + lane;
#pragma unroll
            for (int rr = 0; rr < 2; ++rr) { const int r = wave * 2 + rr; const f32x4* xr = (const f32x4*)(a.in[1] + (size_t)r * DM) + lane; f32x4 v[4]; float s = 0.f;
#pragma unroll
                for (int j = 0; j < 4; ++j) { v[j] = xr[64 * j]; s += (v[j].x * v[j].x + v[j].y * v[j].y) + (v[j].z * v[j].z + v[j].w * v[j].w); }
                const float rstd = 1.0f / sqrtf(wave_sum(s) * (1.0f / DM) + RMS_EPS);
#pragma unroll
                for (int j = 0; j < 4; ++j) { const f32x4 g = gp[64 * j]; f32x4 o; o.x = v[j].x * rstd * g.x; o.y = v[j].y * rstd * g.y; o.z = v[j].z * rstd * g.z; o.w = v[j].w * rstd * g.w;
                    *(LAS f32x4*)(hm + r * 1024 + (64 * j + lane) * 4) = o; } }
        }
        __syncthreads();
        const int cgi = blockIdx.x >> 1, chalf = (blockIdx.x & 1) * 32; int src, dcol, ld; size_t dsto;
        if (cgi < 8) { src = 512 + 64 * cgi; dsto = WS_MKR; ld = 512; dcol = 64 * cgi; }
        else if (cgi < 24) { src = 1024 + 64 * (cgi - 8); dsto = WS_MVR; ld = 1024; dcol = 64 * (cgi - 8); }
        else if (cgi < 28) { src = 4096 + 64 * (cgi - 24); dsto = WS_MKA; ld = 256; dcol = 64 * (cgi - 24); }
        else { src = 4352 + 64 * (cgi - 28); dsto = WS_MVA; ld = 256; dcol = 64 * (cgi - 28); }
        float acc[16];
#pragma unroll
        for (int m = 0; m < 16; ++m) acc[m] = 0.f;
        const int col = lane & 31, kh4 = (lane >> 5) * 4;
        const float* wp = a.in[2] + src + chalf + col;
#pragma unroll 4
        for (int it = 0; it < 16; ++it) {
            const int k = 128 * wave + 8 * it + kh4;
            const float w0 = wp[(size_t)k * INC], w1 = wp[(size_t)(k + 1) * INC], w2 = wp[(size_t)(k + 2) * INC], w3 = wp[(size_t)(k + 3) * INC];
#pragma unroll
            for (int m = 0; m < 16; ++m) { const f32x4 hv = *(const LAS f32x4*)(hm + m * 1024 + k); acc[m] += (hv.x * w0 + hv.y * w1) + (hv.z * w2 + hv.w * w3); }
        }
#pragma unroll
        for (int m = 0; m < 16; ++m) { acc[m] += __shfl_xor(acc[m], 32); if (lane < 32) red[(wave * 16 + m) * 32 + col] = acc[m]; }
        __syncthreads();
        {
            const int m = tid >> 5, c = tid & 31; float s = 0.f;
#pragma unroll
            for (int w = 0; w < 8; ++w) s += red[(w * 16 + m) * 32 + c];
            ((bf16*)(ws + dsto))[m * ld + dcol + chalf + c] = (bf16)f2bf(s);
        }
        __syncthreads();
    }
}

__device__ __forceinline__ float log2_sigmoid(float x) { return -log1pf(__expf(-x)) * 1.4426950408889634f; }
__device__ __forceinline__ void naive_retention(const Args& a, int tid, int G) {
    unsigned char* ws = a.ws;
    const bf16* rq = (const bf16*)(ws + WS_RQ); const bf16* rk = (const bf16*)(ws + WS_RK); const bf16* rv = (const bf16*)(ws + WS_RV); bf16* rg = (bf16*)(ws + WS_RG);
    const bf16* mk = (const bf16*)(ws + WS_MKR); const bf16* mv = (const bf16*)(ws + WS_MVR);
    for (int it = blockIdx.x; it < BATCH * RH * 8; it += G) {
        const int b = it / (RH * 8), h = (it / 8) % RH, t = (it % 8) * 256 + (tid >> 1), half = tid & 1;
        const float l2f = log2_sigmoid(a.in[3][h]), l2b = log2_sigmoid(a.in[4][h]);
        const size_t row = (size_t)b * SEQ + t;
        v4u qp[8];
#pragma unroll
        for (int c = 0; c < 8; ++c) qp[c] = *(const v4u*)(rq + row * 512 + h * 64 + c * 8);
        float acc[64];
#pragma unroll
        for (int e = 0; e < 64; ++e) acc[e] = 0.f;
        for (int s = -NMETA; s < SEQ; ++s) {
            const bf16* kp = s < 0 ? mk + (size_t)(s + NMETA) * 512 + h * 64 : rk + ((size_t)b * SEQ + s) * 512 + h * 64;
            const bf16* vp = (s < 0 ? mv + (size_t)(s + NMETA) * 1024 + h * 128 : rv + ((size_t)b * SEQ + s) * 1024 + h * 128) + half * 64;
            float d = 0.f;
#pragma unroll
            for (int c = 0; c < 8; ++c) { const v4u kk = *(const v4u*)(kp + c * 8); const v4u qq = qp[c];
                d += bflo(qq.x) * bflo(kk.x) + bfhi(qq.x) * bfhi(kk.x) + bflo(qq.y) * bflo(kk.y) + bfhi(qq.y) * bfhi(kk.y) + bflo(qq.z) * bflo(kk.z) + bfhi(qq.z) * bfhi(kk.z) + bflo(qq.w) * bflo(kk.w) + bfhi(qq.w) * bfhi(kk.w); }
            const int dist = t - s;
            const float w = d * 0.125f * exp2f(dist >= 0 ? (float)dist * l2f : (float)(-dist) * l2b);
#pragma unroll
            for (int c = 0; c < 8; ++c) { const v4u vv = *(const v4u*)(vp + c * 8);
                acc[c * 8 + 0] += w * bflo(vv.x); acc[c * 8 + 1] += w * bfhi(vv.x); acc[c * 8 + 2] += w * bflo(vv.y); acc[c * 8 + 3] += w * bfhi(vv.y);
                acc[c * 8 + 4] += w * bflo(vv.z); acc[c * 8 + 5] += w * bfhi(vv.z); acc[c * 8 + 6] += w * bflo(vv.w); acc[c * 8 + 7] += w * bfhi(vv.w); }
        }
        float mu = 0.f;
#pragma unroll
        for (int e = 0; e < 64; ++e) mu += acc[e];
        mu += __shfl_xor(mu, 1); mu *= (1.0f / 128.0f); float var = 0.f;
#pragma unroll
        for (int e = 0; e < 64; ++e) { const float dd = acc[e] - mu; var += dd * dd; }
        var += __shfl_xor(var, 1);
        const float rstd = 1.0f / sqrtf(var * (1.0f / 128.0f) + GN_EPS);
        const float* gn = a.in[5] + h * 128 + half * 64;
#pragma unroll
        for (int c = 0; c < 8; ++c) { bf16* gp = rg + row * 1024 + h * 128 + half * 64 + c * 8; const v4u gg = *(const v4u*)gp; float o[8];
            const float gv[8] = {bflo(gg.x), bfhi(gg.x), bflo(gg.y), bfhi(gg.y), bflo(gg.z), bfhi(gg.z), bflo(gg.w), bfhi(gg.w)};
#pragma unroll
            for (int j = 0; j < 8; ++j) o[j] = gv[j] * sigmoidf_(gv[j]) * ((acc[c * 8 + j] - mu) * rstd * gn[c * 8 + j]);
            v4u w4; w4.x = pk2(o[0], o[1]); w4.y = pk2(o[2], o[3]); w4.z = pk2(o[4], o[5]); w4.w = pk2(o[6], o[7]); *(v4u*)gp = w4; }
    }
}
__device__ __forceinline__ void naive_attention(const Args& a, int tid, int G) {
    unsigned char* ws = a.ws;
    bf16* aq = (bf16*)(ws + WS_AQ); const bf16* ak = (const bf16*)(ws + WS_AK); const bf16* av = (const bf16*)(ws + WS_AV);
    const bf16* mk = (const bf16*)(ws + WS_MKA); const bf16* mv = (const bf16*)(ws + WS_MVA);
    for (int it = blockIdx.x; it < BATCH * AQH * 4; it += G) {
        const int b = it / (AQH * 4), qh = (it / 4) % AQH, t = (it % 4) * 512 + tid, kh = qh / 4;
        const float slope = exp2f(-0.5f * (float)(qh + 1));
        const size_t row = (size_t)b * SEQ + t;
        float q[64];
#pragma unroll
        for (int c = 0; c < 8; ++c) { const v4u qq = *(const v4u*)(aq + row * 1024 + qh * 64 + c * 8);
            q[c * 8 + 0] = bflo(qq.x) * 0.125f; q[c * 8 + 1] = bfhi(qq.x) * 0.125f; q[c * 8 + 2] = bflo(qq.y) * 0.125f; q[c * 8 + 3] = bfhi(qq.y) * 0.125f;
            q[c * 8 + 4] = bflo(qq.z) * 0.125f; q[c * 8 + 5] = bfhi(qq.z) * 0.125f; q[c * 8 + 6] = bflo(qq.w) * 0.125f; q[c * 8 + 7] = bfhi(qq.w) * 0.125f; }
        float mx = a.in[6][qh], l = 1.0f, acc[64];
#pragma unroll
        for (int e = 0; e < 64; ++e) acc[e] = 0.f;
        for (int j = -NMETA; j <= 256; ++j) {
            const int s = t - 128 + j;
            if (j >= 0 && (s < 0 || s >= SEQ)) continue;
            const bf16* kp = j < 0 ? mk + (size_t)(j + NMETA) * 256 + kh * 64 : ak + ((size_t)b * SEQ + s) * 256 + kh * 64;
            const bf16* vp = j < 0 ? mv + (size_t)(j + NMETA) * 256 + kh * 64 : av + ((size_t)b * SEQ + s) * 256 + kh * 64;
            float d = 0.f;
#pragma unroll
            for (int c = 0; c < 8; ++c) { const v4u kk = *(const v4u*)(kp + c * 8);
                d += q[c * 8 + 0] * bflo(kk.x) + q[c * 8 + 1] * bfhi(kk.x) + q[c * 8 + 2] * bflo(kk.y) + q[c * 8 + 3] * bfhi(kk.y) + q[c * 8 + 4] * bflo(kk.z) + q[c * 8 + 5] * bfhi(kk.z) + q[c * 8 + 6] * bflo(kk.w) + q[c * 8 + 7] * bfhi(kk.w); }
            if (j >= 0) { const int dist = j < 128 ? 128 - j : j - 128; d -= slope * (float)dist; }
            const float mn = fmaxf(mx, d), f = __expf(mx - mn), p = __expf(d - mn); mx = mn; l = l * f + p;
#pragma unroll
            for (int c = 0; c < 8; ++c) { const v4u vv = *(const v4u*)(vp + c * 8);
                acc[c * 8 + 0] = acc[c * 8 + 0] * f + p * bflo(vv.x); acc[c * 8 + 1] = acc[c * 8 + 1] * f + p * bfhi(vv.x); acc[c * 8 + 2] = acc[c * 8 + 2] * f + p * bflo(vv.y); acc[c * 8 + 3] = acc[c * 8 + 3] * f + p * bfhi(vv.y);
                acc[c * 8 + 4] = acc[c * 8 + 4] * f + p * bflo(vv.z); acc[c * 8 + 5] = acc[c * 8 + 5] * f + p * bfhi(vv.z); acc[c * 8 + 6] = acc[c * 8 + 6] * f + p * bflo(vv.w); acc[c * 8 + 7] = acc[c * 8 + 7] * f + p * bfhi(vv.w); }
        }
        const float il = 1.0f / l;
#pragma unroll
        for (int c = 0; c < 8; ++c) { v4u w4; w4.x = pk2(acc[c * 8 + 0] * il, acc[c * 8 + 1] * il); w4.y = pk2(acc[c * 8 + 2] * il, acc[c * 8 + 3] * il); w4.z = pk2(acc[c * 8 + 4] * il, acc[c * 8 + 5] * il); w4.w = pk2(acc[c * 8 + 6] * il, acc[c * 8 + 7] * il);
            *(v4u*)(aq + row * 1024 + qh * 64 + c * 8) = w4; }
    }
}

typedef float f32x16 __attribute__((ext_vector_type(16)));
typedef float f32x2_t __attribute__((ext_vector_type(2)));
typedef __bf16 bf16x2_t __attribute__((ext_vector_type(2)));
__device__ __forceinline__ unsigned cvtpk(float lo, float hi) { f32x2_t v = {lo, hi}; bf16x2_t b = __builtin_convertvector(v, bf16x2_t); return __builtin_bit_cast(unsigned, b); }
__device__ __forceinline__ bf16x8 pack8(const f32x16& x, int s) { v4u p; p.x = cvtpk(x[8 * s], x[8 * s + 1]); p.y = cvtpk(x[8 * s + 2], x[8 * s + 3]); p.z = cvtpk(x[8 * s + 4], x[8 * s + 5]); p.w = cvtpk(x[8 * s + 6], x[8 * s + 7]); return __builtin_bit_cast(bf16x8, p); }
__device__ __forceinline__ int crow(int reg, int h) { return (reg & 3) + 8 * (reg >> 2) + 4 * h; }
__device__ __forceinline__ int perm16(int x) { return (x & 3) | ((x & 4) << 1) | ((x & 8) >> 1); }
#define MFMA32(a, b, c) __builtin_amdgcn_mfma_f32_32x32x16_bf16((a), (b), (c), 0, 0, 0)
constexpr int AT_KROW = 144, AT_VROW = 848, AT_KIMG = 0, AT_VT = 416 * AT_KROW;
static_assert(AT_VT + 64 * AT_VROW <= 131072, "attention LDS");

__device__ __forceinline__ void attn_unit(const Args& a, LAS unsigned char* lds, int unit, int tid, int lane, int wave, bf16* attbase) {
    unsigned char* ws = a.ws;
    bf16* aq = (bf16*)(ws + WS_AQ); const bf16* ak = (const bf16*)(ws + WS_AK); const bf16* av = (const bf16*)(ws + WS_AV);
    const bf16* mk = (const bf16*)(ws + WS_MKA); const bf16* mv = (const bf16*)(ws + WS_MVA);
    const int n = unit & 15, kh = (unit >> 4) & 3, b = unit >> 6;
    const size_t rowb = (size_t)b * SEQ;
    for (int i = tid; i < 400 * 8; i += NTHR) {
        const int row = i >> 3, pc = i & 7; const bf16* src; int irow;
        if (row < 16) { src = mk + (size_t)row * 256 + kh * 64 + pc * 8; irow = row; }
        else { const int j = row - 16, t = 128 * (n - 1) + j; if (t < 0 || t >= SEQ) continue; src = ak + (rowb + t) * 256 + kh * 64 + pc * 8; irow = 32 + j; }
        *(LAS v4u*)(lds + AT_KIMG + irow * AT_KROW + pc * 16) = *(const v4u*)src;
    }
    for (int i = tid; i < 200 * 8; i += NTHR) {
        const int pr = i >> 3, pc = i & 7; const bf16* src; int pos;
        if (pr < 8) { src = mv + (size_t)(2 * pr) * 256 + kh * 64 + pc * 8; pos = perm16(2 * pr); }
        else { const int j = 2 * (pr - 8), t = 128 * (n - 1) + j; if (t < 0 || t >= SEQ) continue; src = av + (rowb + t) * 256 + kh * 64 + pc * 8; pos = 32 + (j & ~15) + perm16(j & 15); }
        const v4u v0 = *(const v4u*)src, v1 = *(const v4u*)(src + 256);
        LAS unsigned char* dst = lds + AT_VT + (pc * 8) * AT_VROW + pos * 2;
        *(LAS unsigned*)(dst + 0 * AT_VROW) = (v0.x & 0xffffu) | (v1.x << 16); *(LAS unsigned*)(dst + 1 * AT_VROW) = (v0.x >> 16) | (v1.x & 0xffff0000u);
        *(LAS unsigned*)(dst + 2 * AT_VROW) = (v0.y & 0xffffu) | (v1.y << 16); *(LAS unsigned*)(dst + 3 * AT_VROW) = (v0.y >> 16) | (v1.y & 0xffff0000u);
        *(LAS unsigned*)(dst + 4 * AT_VROW) = (v0.z & 0xffffu) | (v1.z << 16); *(LAS unsigned*)(dst + 5 * AT_VROW) = (v0.z >> 16) | (v1.z & 0xffff0000u);
        *(LAS unsigned*)(dst + 6 * AT_VROW) = (v0.w & 0xffffu) | (v1.w << 16); *(LAS unsigned*)(dst + 7 * AT_VROW) = (v0.w >> 16) | (v1.w & 0xffff0000u);
    }
    __syncthreads();
    const int r = lane & 31, h = lane >> 5;
    constexpr float L2E = 1.4426950408889634f;
#pragma unroll 1
    for (int rep = 0; rep < 2; ++rep) {
        const int tt = wave + 8 * rep, g = tt >> 2, p = tt & 3, qh = kh * 4 + g;
        const size_t qrow = rowb + 128 * n + 32 * p + r;
        bf16* qp = aq + qrow * 1024 + qh * 64; bf16* op = attbase + qrow * 1024 + qh * 64;
        bf16x8 qf[4];
#pragma unroll
        for (int ds = 0; ds < 4; ++ds) qf[ds] = *(const bf16x8*)(qp + 16 * ds + 8 * h);
        const float slope2 = exp2f(-0.5f * (float)(qh + 1)) * L2E, sc = 0.125f * L2E;
        float m = a.in[6][qh] * L2E, l = h == 0 ? 1.0f : 0.0f;
        f32x16 o0, o1;
#pragma unroll
        for (int i = 0; i < 16; ++i) { o0[i] = 0.f; o1[i] = 0.f; }
#pragma unroll 1
        for (int cc = -1; cc < 9; ++cc) {
            const int cj = p + cc;
            if (cc >= 0) { const int blk = n - 1 + (cj >> 2); if (blk < 0 || blk > 15) continue; }
            const int rowbase = cc < 0 ? 0 : 32 + 32 * cj;
            f32x16 s;
#pragma unroll
            for (int i = 0; i < 16; ++i) s[i] = 0.f;
            const LAS unsigned char* kp = lds + AT_KIMG + (rowbase + r) * AT_KROW + 16 * h;
#pragma unroll
            for (int ds = 0; ds < 4; ++ds) s = MFMA32(*(const LAS bf16x8*)(kp + 32 * ds), qf[ds], s);
            float mc = -INFINITY;
            {
                const float dq0 = (float)(32 * cc + 4 * h - 128 - r), sl = cc < 0 ? 0.f : slope2, lim = (cc == 0 || cc == 8) ? 128.0f : 1e9f;
#pragma unroll
                for (int i = 0; i < 16; ++i) { const float dq = fabsf(dq0 + (float)((i & 3) + 8 * (i >> 2))); float t = s[i] * sc - sl * dq;
                    t = dq > lim ? -INFINITY : t;
                    if (i >= 8 && cc < 0) t = -INFINITY;
                    s[i] = t; mc = fmaxf(mc, t); }
            }
            mc = fmaxf(mc, __shfl_xor(mc, 32));
            const float mn = fmaxf(m, mc);
            if (__any(mn > m)) { const float al = exp2f(m - mn); l *= al;
#pragma unroll
                for (int i = 0; i < 16; ++i) { o0[i] *= al; o1[i] *= al; } }
            m = mn;
            float ls = 0.f;
#pragma unroll
            for (int i = 0; i < 16; ++i) { s[i] = exp2f(s[i] - m); ls += s[i]; }
            l += ls;
            const LAS unsigned char* vp = lds + AT_VT + r * AT_VROW + (rowbase + 8 * h) * 2;
            {
                const bf16x8 pk = pack8(s, 0);
                o0 = MFMA32(*(const LAS bf16x8*)(vp), pk, o0);
                o1 = MFMA32(*(const LAS bf16x8*)(vp + 32 * AT_VROW), pk, o1);
            }
            if (cc >= 0) {
                const bf16x8 pk = pack8(s, 1);
                o0 = MFMA32(*(const LAS bf16x8*)(vp + 32), pk, o0);
                o1 = MFMA32(*(const LAS bf16x8*)(vp + 32 * AT_VROW + 32), pk, o1);
            }
        }
        l += __shfl_xor(l, 32);
        const float il = 1.0f / l;
#pragma unroll
        for (int gq = 0; gq < 4; ++gq) {
            v2u w0, w1;
            w0.x = cvtpk(o0[4 * gq] * il, o0[4 * gq + 1] * il); w0.y = cvtpk(o0[4 * gq + 2] * il, o0[4 * gq + 3] * il);
            w1.x = cvtpk(o1[4 * gq] * il, o1[4 * gq + 1] * il); w1.y = cvtpk(o1[4 * gq + 2] * il, o1[4 * gq + 3] * il);
            *(v2u*)(op + 8 * gq + 4 * h) = w0; *(v2u*)(op + 32 + 8 * gq + 4 * h) = w1;
        }
    }
    __syncthreads();
}
__device__ __forceinline__ void attn_phase(const Args& a, LAS unsigned char* lds, int tid, int lane, int wave, int G, bf16* attbase) {
    for (int u = blockIdx.x; u < BATCH * AKH * 16; u += G) attn_unit(a, lds, u, tid, lane, wave, attbase);
}

constexpr size_t WS_SB = 464 * MiB;
constexpr int RT_ROWK = 144, RT_ROWT = 272;
constexpr int RT_KIMG = 0, RT_KT = RT_KIMG + 128 * RT_ROWK, RT_VT = RT_KT + 64 * RT_ROWT, RT_STF = RT_VT + 128 * RT_ROWT, RT_STB = RT_STF + 128 * RT_ROWK, RT_XCH = RT_STB + 128 * RT_ROWK, RT_GN = RT_XCH + 2048, RT_END = RT_GN + 512;
static_assert(RT_END <= 131072, "retention LDS");

__device__ __forceinline__ void rt_put_t(LAS unsigned char* img, int j0, int c0, v4u r0, v4u r1, float s0, float s1, bool scale) {
    const int pos = (j0 & ~15) + perm16(j0 & 15);
    LAS unsigned char* dst = img + c0 * RT_ROWT + pos * 2;
    const unsigned a[4] = {r0.x, r0.y, r0.z, r0.w}, bq[4] = {r1.x, r1.y, r1.z, r1.w};
#pragma unroll
    for (int q = 0; q < 4; ++q) {
        unsigned lo, hi;
        if (scale) { lo = cvtpk(bflo(a[q]) * s0, bflo(bq[q]) * s1); hi = cvtpk(bfhi(a[q]) * s0, bfhi(bq[q]) * s1); }
        else { lo = (a[q] & 0xffffu) | (bq[q] << 16); hi = (a[q] >> 16) | (bq[q] & 0xffff0000u); }
        *(LAS unsigned*)(dst + (2 * q) * RT_ROWT) = lo; *(LAS unsigned*)(dst + (2 * q + 1) * RT_ROWT) = hi;
    }
}
__device__ __forceinline__ void rt_tile_to_img(LAS unsigned char* img, const f32x16& t, int eb, int db, int r, int h) {
#pragma unroll
    for (int i = 0; i < 16; ++i) *(LAS unsigned short*)(img + (32 * eb + crow(i, h)) * RT_ROWK + (32 * db + r) * 2) = (unsigned short)f2bf(t[i]);
}

__device__ __forceinline__ void rt_tile_to_global(bf16* img, const f32x16& t, int eb, int db, int r, int h) {
#pragma unroll
    for (int i = 0; i < 16; ++i) img[(32 * eb + crow(i, h)) * 64 + 32 * db + r] = (bf16)f2bf(t[i]);
}
constexpr int R1_SET = 53248, R1_KT = 0, R1_VT = 17408;
static_assert(2 * R1_SET <= 131072 && R1_VT + 128 * RT_ROWT <= R1_SET, "retention pass-1 LDS");

__device__ __forceinline__ void ret_unit(const Args& a, LAS unsigned char* lds, int unit, int tid_, int lane_, int wave, bf16* retbase) {
    const int tid = tid_, lane = lane_;
    unsigned char* ws = a.ws;
    const int b = unit >> 3, hd = unit & 7;
    const size_t rowb = (size_t)b * SEQ;
    const bf16* rq = (const bf16*)(ws + WS_RQ) + hd * 64; const bf16* rk = (const bf16*)(ws + WS_RK) + hd * 64; const bf16* rv = (const bf16*)(ws + WS_RV) + hd * 128; const bf16* rg = (const bf16*)(ws + WS_RG) + hd * 128;
    const bf16* mk = (const bf16*)(ws + WS_MKR) + hd * 64; const bf16* mv = (const bf16*)(ws + WS_MVR) + hd * 128;
    bf16* sbg = (bf16*)(ws + WS_SB) + (size_t)unit * 16 * 8192;
    const float l2f = log2_sigmoid(a.in[3][hd]), l2b = log2_sigmoid(a.in[4][hd]);
    const float cdf = exp2f(128.0f * l2f), cdb = exp2f(128.0f * l2b);
    const int r = lane & 31, h = lane >> 5;
    const int pj0 = 2 * (tid >> 3), pc = tid & 7;
    const float kb0 = exp2f(l2b * (float)pj0 - 3.0f), kb1 = exp2f(l2b * (float)(pj0 + 1) - 3.0f);
    const int eb_s = wave >> 1, db_s = wave & 1;
    f32x16 tile;
    v4u pk0, pk1, pv0, pv1, pv2, pv3;
    const unsigned kofs = (unsigned)(pj0 * 512 + pc * 8), vofs = (unsigned)(pj0 * 1024 + pc * 8);
#define RT_LOAD_K(c) do { const bf16* kp_ = rk + (rowb + 128 * (c)) * 512; pk0 = *(const v4u*)(kp_ + kofs); pk1 = *(const v4u*)(kp_ + kofs + 512); } while (0)
#define RT_LOAD_V(c) do { const bf16* vp_ = rv + (rowb + 128 * (c)) * 1024; pv0 = *(const v4u*)(vp_ + vofs); pv1 = *(const v4u*)(vp_ + vofs + 1024); pv2 = *(const v4u*)(vp_ + vofs + 64); pv3 = *(const v4u*)(vp_ + vofs + 1024 + 64); } while (0)
#define RT_LOAD_KV(c) do { RT_LOAD_K(c); RT_LOAD_V(c); } while (0)
#pragma unroll
    for (int i = 0; i < 16; ++i) tile[i] = 0.f;
    RT_LOAD_KV(15);
    { LAS unsigned char* S_ = lds + (15 & 1) * R1_SET; rt_put_t(S_ + R1_KT, pj0, pc * 8, pk0, pk1, kb0, kb1, true); rt_put_t(S_ + R1_VT, pj0, pc * 8, pv0, pv1, 0.f, 0.f, false); rt_put_t(S_ + R1_VT, pj0, pc * 8 + 64, pv2, pv3, 0.f, 0.f, false); }
    RT_LOAD_KV(14);
    __syncthreads();
#pragma unroll 1
    for (int c = 15; c >= 1; --c) {
        rt_tile_to_global(sbg + (size_t)c * 8192, tile, eb_s, db_s, r, h);
        if (c >= 2) { LAS unsigned char* S_ = lds + ((c - 1) & 1) * R1_SET; rt_put_t(S_ + R1_KT, pj0, pc * 8, pk0, pk1, kb0, kb1, true); rt_put_t(S_ + R1_VT, pj0, pc * 8, pv0, pv1, 0.f, 0.f, false); rt_put_t(S_ + R1_VT, pj0, pc * 8 + 64, pv2, pv3, 0.f, 0.f, false); }
        if (c >= 3) RT_LOAD_KV(c - 2);
        const LAS unsigned char* vtA = lds + (c & 1) * R1_SET + R1_VT + (32 * eb_s + r) * RT_ROWT + 16 * h;
        const LAS unsigned char* ktB = lds + (c & 1) * R1_SET + R1_KT + (32 * db_s + r) * RT_ROWT + 16 * h;
#pragma unroll
        for (int i = 0; i < 16; ++i) tile[i] *= cdb;
#pragma unroll
        for (int s = 0; s < 8; ++s) tile = MFMA32(*(const LAS bf16x8*)(vtA + 32 * s), *(const LAS bf16x8*)(ktB + 32 * s), tile);
        __syncthreads();
    }
    rt_tile_to_global(sbg, tile, eb_s, db_s, r, h);
    int tid_o = tid_; asm volatile("" : "+v"(tid_o));
    {
    const int tid = tid_o, lane = tid & 63, r = lane & 31, h = lane >> 5;
    const int pj0 = 2 * (tid >> 3), pc = tid & 7;
    const float kf0 = exp2f(l2f * (float)(127 - pj0) - 3.0f), kf1 = exp2f(l2f * (float)(126 - pj0) - 3.0f);
    const unsigned kofs = (unsigned)(pj0 * 512 + pc * 8), vofs = (unsigned)(pj0 * 1024 + pc * 8);
    const LAS unsigned char* vtA = lds + RT_VT + (32 * eb_s + r) * RT_ROWT + 16 * h;
    const LAS unsigned char* ktB = lds + RT_KT + (32 * db_s + r) * RT_ROWT + 16 * h;
#pragma unroll
    for (int i = 0; i < 16; ++i) tile[i] = 0.f;
    {
        v4u k0 = {0u, 0u, 0u, 0u}, k1 = k0, v0 = k0, v1 = k0, v2 = k0, v3 = k0;
        if (pj0 >= 112) { const bf16* kp = mk + (size_t)(pj0 - 112) * 512 + pc * 8; k0 = *(const v4u*)kp; k1 = *(const v4u*)(kp + 512);
            const bf16* vp = mv + (size_t)(pj0 - 112) * 1024 + pc * 8; v0 = *(const v4u*)vp; v1 = *(const v4u*)(vp + 1024); v2 = *(const v4u*)(vp + 64); v3 = *(const v4u*)(vp + 1024 + 64); }
        RT_LOAD_KV(0);
        rt_put_t(lds + RT_KT, pj0, pc * 8, k0, k1, kf0, kf1, true);
        rt_put_t(lds + RT_VT, pj0, pc * 8, v0, v1, 0.f, 0.f, false); rt_put_t(lds + RT_VT, pj0, pc * 8 + 64, v2, v3, 0.f, 0.f, false);
        __syncthreads();
#pragma unroll
        for (int s = 0; s < 8; ++s) tile = MFMA32(*(const LAS bf16x8*)(vtA + 32 * s), *(const LAS bf16x8*)(ktB + 32 * s), tile);
        __syncthreads();
    }
    const int qt = wave & 3, eh = wave >> 2;
    const float cf = exp2f(l2f * (float)(32 * qt + r + 1)), cb = exp2f(l2b * (float)(128 - 32 * qt - r));
    v4u ps0, ps1;
    bf16x8 qf[4];
    if (tid < 128) ((LAS float*)(lds + RT_GN))[tid] = a.in[5][hd * 128 + tid];
    asm volatile("s_waitcnt vmcnt(0)" ::: "memory"); __syncthreads();
    const unsigned sofs = (unsigned)((tid >> 3) * 64 + (tid & 7) * 8), qofs = (unsigned)((32 * qt + r) * 512 + 8 * h), gofs = (unsigned)((32 * qt + r) * 1024 + 64 * eh + 4 * h);
#define RT_LOAD_SB(c) do { const bf16* sp_ = sbg + (size_t)(c) * 8192; ps0 = *(const v4u*)(sp_ + sofs); ps1 = *(const v4u*)(sp_ + sofs + 4096); } while (0)
#define RT_LOAD_Q(dst, c) do { const bf16* qp_ = rq + (rowb + 128 * (c)) * 512; _Pragma("unroll") for (int ds = 0; ds < 4; ++ds) dst[ds] = *(const bf16x8*)(qp_ + qofs + 16 * ds); } while (0)
    RT_LOAD_SB(0); RT_LOAD_Q(qf, 0);
#pragma unroll 1
    for (int c = 0; c < 16; ++c) {
        rt_tile_to_img(lds + RT_STF, tile, eb_s, db_s, r, h);
        *(LAS v4u*)(lds + RT_KIMG + pj0 * RT_ROWK + pc * 16) = pk0; *(LAS v4u*)(lds + RT_KIMG + (pj0 + 1) * RT_ROWK + pc * 16) = pk1;
        rt_put_t(lds + RT_KT, pj0, pc * 8, pk0, pk1, kf0, kf1, true);
        rt_put_t(lds + RT_VT, pj0, pc * 8, pv0, pv1, 0.f, 0.f, false); rt_put_t(lds + RT_VT, pj0, pc * 8 + 64, pv2, pv3, 0.f, 0.f, false);
        *(LAS v4u*)(lds + RT_STB + (tid >> 3) * RT_ROWK + (tid & 7) * 16) = ps0; *(LAS v4u*)(lds + RT_STB + (64 + (tid >> 3)) * RT_ROWK + (tid & 7) * 16) = ps1;
        __syncthreads();
        const bf16* rg_c = rg + (rowb + 128 * c) * 1024; bf16* op_c = retbase + hd * 128 + (rowb + 128 * c) * 1024;
        bf16x8 pk[4][2];
#pragma unroll
        for (int kc = 0; kc < 4; ++kc) {
            f32x16 s;
#pragma unroll
            for (int i = 0; i < 16; ++i) s[i] = 0.f;
            const LAS unsigned char* kp = lds + RT_KIMG + (32 * kc + r) * RT_ROWK + 16 * h;
#pragma unroll
            for (int ds = 0; ds < 4; ++ds) s = MFMA32(*(const LAS bf16x8*)(kp + 32 * ds), qf[ds], s);
            float d0 = (float)(32 * qt + r - 32 * kc - 4 * h); asm volatile("" : "+v"(d0));
#pragma unroll
            for (int i = 0; i < 16; ++i) { const float df = d0 - (float)((i & 3) + 8 * (i >> 2)); s[i] *= __builtin_amdgcn_exp2f(fminf(l2f * df, -l2b * df) - 3.0f); }
            pk[kc][0] = pack8(s, 0); pk[kc][1] = pack8(s, 1);
            __builtin_amdgcn_sched_barrier(0);
        }
        f32x16 o[2];
#pragma unroll
        for (int e2 = 0; e2 < 2; ++e2) {
            const int eb = 2 * eh + e2;
            f32x16 acc, xf, xb;
#pragma unroll
            for (int i = 0; i < 16; ++i) { acc[i] = 0.f; xf[i] = 0.f; xb[i] = 0.f; }
            const LAS unsigned char* vp = lds + RT_VT + (32 * eb + r) * RT_ROWT + 16 * h;
#pragma unroll
            for (int kc = 0; kc < 4; ++kc) { acc = MFMA32(*(const LAS bf16x8*)(vp + 64 * kc), pk[kc][0], acc); acc = MFMA32(*(const LAS bf16x8*)(vp + 64 * kc + 32), pk[kc][1], acc); }
            const LAS unsigned char* fp = lds + RT_STF + (32 * eb + r) * RT_ROWK + 16 * h; const LAS unsigned char* bp = lds + RT_STB + (32 * eb + r) * RT_ROWK + 16 * h;
#pragma unroll
            for (int ds = 0; ds < 4; ++ds) { xf = MFMA32(*(const LAS bf16x8*)(fp + 32 * ds), qf[ds], xf); xb = MFMA32(*(const LAS bf16x8*)(bp + 32 * ds), qf[ds], xb); }
#pragma unroll
            for (int i = 0; i < 16; ++i) o[e2][i] = acc[i] + cf * xf[i] + cb * xb[i];
            __builtin_amdgcn_sched_barrier(0);
        }
        float s1 = 0.f, s2 = 0.f;
#pragma unroll
        for (int e2 = 0; e2 < 2; ++e2)
#pragma unroll
            for (int i = 0; i < 16; ++i) { s1 += o[e2][i]; s2 += o[e2][i] * o[e2][i]; }
        s1 += __shfl_xor(s1, 32); s2 += __shfl_xor(s2, 32);
        LAS float* xch = (LAS float*)(lds + RT_XCH);
        if (h == 0) { xch[(eh * 128 + 32 * qt + r) * 2] = s1; xch[(eh * 128 + 32 * qt + r) * 2 + 1] = s2; }
        __builtin_amdgcn_sched_barrier(0);
#pragma unroll
        for (int i = 0; i < 16; ++i) tile[i] *= cdf;
#pragma unroll
        for (int s = 0; s < 8; ++s) tile = MFMA32(*(const LAS bf16x8*)(vtA + 32 * s), *(const LAS bf16x8*)(ktB + 32 * s), tile);
        __syncthreads();
        if (c < 15) { RT_LOAD_K(c + 1); RT_LOAD_SB(c + 1); RT_LOAD_V(c + 1); RT_LOAD_Q(qf, c + 1); }
        __builtin_amdgcn_sched_barrier(0);
        {
            const float p1 = xch[((eh ^ 1) * 128 + 32 * qt + r) * 2], p2 = xch[((eh ^ 1) * 128 + 32 * qt + r) * 2 + 1];
            const float mu = (s1 + p1) * (1.0f / 128.0f), var = (s2 + p2) * (1.0f / 128.0f) - mu * mu, rstd = 1.0f / sqrtf(fmaxf(var, 0.f) + GN_EPS);
            const LAS float* gn = (const LAS float*)(lds + RT_GN) + 64 * eh + 4 * h;
#pragma unroll
            for (int e2 = 0; e2 < 2; ++e2)
#pragma unroll
                for (int gq = 0; gq < 4; ++gq) { const int e0 = 32 * e2 + 8 * gq; const v2u g2 = *(const v2u*)(rg_c + gofs + e0); const f32x4 gv = *(const LAS f32x4*)(gn + e0);
                    const float g0 = bflo(g2.x), g1 = bfhi(g2.x), g2f = bflo(g2.y), g3 = bfhi(g2.y);
                    v2u w; w.x = cvtpk(g0 * sigmoidf_(g0) * ((o[e2][4 * gq] - mu) * rstd * gv.x), g1 * sigmoidf_(g1) * ((o[e2][4 * gq + 1] - mu) * rstd * gv.y));
                    w.y = cvtpk(g2f * sigmoidf_(g2f) * ((o[e2][4 * gq + 2] - mu) * rstd * gv.z), g3 * sigmoidf_(g3) * ((o[e2][4 * gq + 3] - mu) * rstd * gv.w));
                    *(v2u*)(op_c + gofs + e0) = w; }
        }
    }
    }
#undef RT_LOAD_KV
#undef RT_LOAD_K
#undef RT_LOAD_V
#undef RT_LOAD_SB
#undef RT_LOAD_Q
    __syncthreads();
}

#define XB_TMO      128
#define XB_XCNT(j)  (256  + 64 * (j))
#define XB_XSUB(j)  (1280 + 64 * (j))
#define XB_XGEN(j)  (2304 + 64 * (j))
#define XB_TOP      3328
#define XB_TOPGEN   3392
#define XCD_BAR_WORDS 3456
#define XB_SPIN_CAP (1u << 18)

__device__ __forceinline__ unsigned xb_ld(unsigned* p)              { return __hip_atomic_load(p, __ATOMIC_RELAXED, __HIP_MEMORY_SCOPE_AGENT); }
__device__ __forceinline__ unsigned xb_add(unsigned* p, unsigned v) { return __hip_atomic_fetch_add(p, v, __ATOMIC_RELAXED, __HIP_MEMORY_SCOPE_AGENT); }
__device__ __forceinline__ unsigned xb_xcc_id() { return (unsigned)__builtin_amdgcn_s_getreg((3 << 11) | 20) & 0xFu; }
#define XB_SPIN(cond, bar) do { unsigned _sp = 0; while (cond) { __builtin_amdgcn_s_sleep(1); \
    if ((++_sp & 255u) == 0u) { if (xb_ld(&(bar)[XB_TMO])) break; if (_sp > XB_SPIN_CAP) { atomicAdd(&(bar)[XB_TMO], 1u); break; } } } } while (0)

struct XcdBarrier {
    unsigned* bar; unsigned x;
    volatile LAS unsigned* st;
};

__device__ __forceinline__ XcdBarrier xcd_barrier_post(unsigned* bar, volatile LAS unsigned* st) {
    XcdBarrier b; b.bar = bar; b.x = xb_xcc_id(); b.st = st;
    if (threadIdx.x == 0) (void)xb_add(&bar[XB_XCNT(b.x)], 1u);
    return b;
}
__device__ __forceinline__ void xcd_barrier_complete(unsigned* bar, unsigned x, unsigned& nloc, unsigned& nx) {
    const unsigned G = gridDim.x * gridDim.y * gridDim.z;
    unsigned sum, cnt, mine, sp = 0u;
    for (;;) {
        sum = 0u; cnt = 0u; mine = 0u;
#pragma unroll
        for (unsigned j = 0; j < 16; ++j) { const unsigned c = xb_ld(&bar[XB_XCNT(j)]); sum += c; cnt += (c > 0u) ? 1u : 0u; mine = (j == x) ? c : mine; }
        if (sum == G) break;
        __builtin_amdgcn_s_sleep(1);
        if ((++sp & 255u) == 0u) { if (xb_ld(&bar[XB_TMO])) break; if (sp > XB_SPIN_CAP) { atomicAdd(&bar[XB_TMO], 1u); break; } }
    }
    nloc = mine > 0u ? mine : 1u; nx = cnt > 0u ? cnt : 1u;
}

__device__ __forceinline__ void xcd_barrier(const XcdBarrier& b) {
    asm volatile("s_waitcnt vmcnt(0)" ::: "memory");
    __syncthreads();
    if (threadIdx.x == 0) {
        unsigned* bar = b.bar;
        __builtin_amdgcn_s_waitcnt(0);
        unsigned nloc = b.st[0], nx = b.st[1];
        if (nloc == 0u) { xcd_barrier_complete(bar, b.x, nloc, nx); b.st[0] = nloc; b.st[1] = nx; }
        const unsigned old = xb_add(&bar[XB_XSUB(b.x)], 1u);
        const unsigned gen = old / nloc;
        if (old + 1u == (gen + 1u) * nloc) {
            __builtin_amdgcn_fence(__ATOMIC_RELEASE, "agent");
            asm volatile("s_waitcnt vmcnt(0)" ::: "memory");
            const unsigned og = xb_add(&bar[XB_TOP], 1u);
            const unsigned tg = og / nx;
            if (og + 1u == (tg + 1u) * nx) xb_add(&bar[XB_TOPGEN], 1u);
            else XB_SPIN(xb_ld(&bar[XB_TOPGEN]) == tg, bar);
            __builtin_amdgcn_fence(__ATOMIC_ACQUIRE, "agent");
            xb_add(&bar[XB_XGEN(b.x)], 1u);
            asm volatile("s_waitcnt vmcnt(0)" ::: "memory");
        } else {
            XB_SPIN(xb_ld(&bar[XB_XGEN(b.x)]) == gen, bar);
            __builtin_amdgcn_fence(__ATOMIC_ACQUIRE, "agent");
            asm volatile("s_waitcnt vmcnt(0)" ::: "memory");
        }
    }
    __syncthreads();
}
constexpr int CW_QUEUE = 8192;
constexpr int MISC_OFF = 131072 + 320;
constexpr int LDS_BYTES = 147456;
#ifndef MK_N_LAUNCHES
#define MK_N_LAUNCHES 1
#endif
__global__ void __launch_bounds__(NTHR, 2) fwd_megakernel(Args a) {
    extern __shared__ __attribute__((aligned(16))) unsigned char lds_raw[];
    LAS unsigned char* lds = (LAS unsigned char*)lds_raw;
    const int tid = threadIdx.x, lane = tid & 63, wave = __builtin_amdgcn_readfirstlane(tid >> 6), G = gridDim.x;
    cg::grid_group grid = cg::this_grid();
    volatile LAS unsigned* MISC = (volatile LAS unsigned*)(lds + MISC_OFF);
    if (tid < 32) MISC[tid] = 0u;
    __syncthreads();
    XcdBarrier bar = xcd_barrier_post((unsigned*)(a.ws + WS_CTL), MISC + 8);
    unsigned char* ws = a.ws;
    const int lo = a.ph_lo, hi = a.ph_hi;
#define IN(k) (lo <= (k) && (k) < hi)
#ifdef PROBE_PHASE
    unsigned long long tsv[NPH + 1]; tsv[0] = __builtin_amdgcn_s_memrealtime();
#define SEAM(k) do { if (IN(k) && IN((k) + 1)) grid.sync(); tsv[(k) + 1] = __builtin_amdgcn_s_memrealtime(); } while (0)
#elif defined(PROBE_DUP_SYNC)
#define SEAM(k) do { if (IN(k) && IN((k) + 1)) { grid.sync(); grid.sync(); } } while (0)
#else
#define SEAM(k) do { if (IN(k) && IN((k) + 1)) xcd_barrier(bar); } while (0)
#endif
    if (hi > NPH) grid.sync();

    if (IN(0)) p0_prologue(a, lds, tid, lane, wave, G);
#ifdef PROBE_DUP_P0
    if (IN(0)) { __syncthreads(); p0_prologue(a, lds, tid, lane, wave, G); }
#endif
    SEAM(0);
    if (IN(1)) {
        pg8::Gemm g{(const pg8::bf16_t*)a.out, (const pg8::bf16_t*)(ws + WS_WIN), M, INC, 1024}; pg8::StaticOrder S; S.init(M, INC, G, (int)blockIdx.x);
        Epi1 E{ws};
        pg8::gemm_phase<Epi1, pg8::StaticOrder, true, true>(lds, g, S, E);
#ifdef PROBE_DUP_P1
        pg8::gemm_phase<Epi1, pg8::StaticOrder, true, true>(lds, g, S, E);
#endif
    }
    SEAM(1);
    if (IN(2)) {
#ifdef PROBE_DUP_RET
        for (int u = blockIdx.x; u < BATCH * RH; u += G) ret_unit(a, lds, u, tid, lane, wave, (bf16*)a.out);
#endif
        for (int u = blockIdx.x; u < BATCH * RH; u += G) ret_unit(a, lds, u, tid, lane, wave, (bf16*)(ws + WS_RG));
        unsigned* qhead = (unsigned*)(ws + WS_CTL) + CW_QUEUE;
        for (;;) {
            if (tid == 0) MISC[0] = __hip_atomic_fetch_add(qhead, 1u, __ATOMIC_RELAXED, __HIP_MEMORY_SCOPE_AGENT);
            __syncthreads();
            const int u = (int)MISC[0];
            if (u >= BATCH * AKH * 16) break;
            attn_unit(a, lds, u, tid, lane, wave, (bf16*)(ws + WS_AQ));
        }
    }
    SEAM(2);
    if (IN(3)) {
        pg8::Gemm g{(const pg8::bf16_t*)(ws + WS_RG), (const pg8::bf16_t*)(ws + WS_WBR), 2 * M, 2048, 1024}; Sched3 S; S.S.init(M, 1024, G, (int)blockIdx.x);
        Epi3 E{(const bf16*)(ws + WS_GA), (const bf16*)(ws + WS_GB), (bf16*)(ws + WS_GB)};
        pg8::gemm_phase<Epi3, Sched3, true, true>(lds, g, S, E);
    }
    SEAM(3);
    if (IN(4)) {
        pg8::Gemm g{(const pg8::bf16_t*)(ws + WS_GB), (const pg8::bf16_t*)(ws + WS_WO), M, 1024, 1024}; pg8::StaticOrder S; S.init(M, 1024, G, (int)blockIdx.x);
        EpiRes<true> E{a.in[0], a.out, (bf16*)(ws + WS_XB), (float*)(ws + WS_SSQ1)};
        pg8::gemm_phase<EpiRes<true>, pg8::StaticOrder, true, true>(lds, g, S, E);
#ifdef PROBE_DUP_P4
        pg8::gemm_phase<EpiRes<true>, pg8::StaticOrder, true, true>(lds, g, S, E);
#endif
    }
    SEAM(4);
    if (IN(5)) {
        pg8::Gemm g{(const pg8::bf16_t*)(ws + WS_XB), (const pg8::bf16_t*)(ws + WS_WGU), M, 2 * DFF, 1024}; pg8::StaticOrder S; S.init(M, 2 * DFF, G, (int)blockIdx.x);
        Epi5 E{(bf16*)(ws + WS_ACT), (const float*)(ws + WS_SSQ1)};
        pg8::gemm_phase<Epi5, pg8::StaticOrder, true, true>(lds, g, S, E);
#ifdef PROBE_DUP_P5
        pg8::gemm_phase<Epi5, pg8::StaticOrder, true, true>(lds, g, S, E);
#endif
    }
    SEAM(5);
    if (IN(6)) {
        pg8::Gemm g{(const pg8::bf16_t*)(ws + WS_ACT), (const pg8::bf16_t*)(ws + WS_WD), M, 1024, DFF}; pg8::StaticOrder S; S.init(M, 1024, G, (int)blockIdx.x);
#ifdef PROBE_DUP_P6
        { EpiRes<false> E0{a.out, (float*)(ws + WS_GA), nullptr, (float*)(ws + WS_SSQ1)}; pg8::gemm_phase<EpiRes<false>, pg8::StaticOrder, true, true>(lds, g, S, E0); }
#endif
        EpiRes<false> E{a.out, a.out, nullptr, (float*)(ws + WS_SSQ2)};
        pg8::gemm_phase<EpiRes<false>, pg8::StaticOrder, true, true>(lds, g, S, E);
    }
    SEAM(6);
    if (IN(7)) {
        const int gw = blockIdx.x * NWAVES + wave, NGW = G * NWAVES;
        const f32x4* gp = (const f32x4*)a.in[14] + lane; f32x4 g[4];
#pragma unroll
        for (int j = 0; j < 4; ++j) g[j] = gp[64 * j];
        const float* ssq = (const float*)(ws + WS_SSQ2);
        for (int m = gw; m < M; m += NGW) {
            const f32x4* sp = (const f32x4*)(ssq + (size_t)m * 16); const f32x4 s0 = sp[0], s1 = sp[1], s2 = sp[2], s3 = sp[3];
            const float tot = ((s0[0] + s0[1]) + (s0[2] + s0[3])) + ((s1[0] + s1[1]) + (s1[2] + s1[3])) + ((s2[0] + s2[1]) + (s2[2] + s2[3])) + ((s3[0] + s3[1]) + (s3[2] + s3[3]));
            const float rstd = 1.0f / sqrtf(tot * (1.0f / DM) + RMS_EPS);
            f32x4* xr = (f32x4*)(a.out + (size_t)m * DM) + lane;
#pragma unroll
            for (int j = 0; j < 4; ++j) { f32x4 v = xr[64 * j]; v.x *= rstd * g[j].x; v.y *= rstd * g[j].y; v.z *= rstd * g[j].z; v.w *= rstd * g[j].w; xr[64 * j] = v; }
        }
    }
#ifdef PROBE_PHASE
    tsv[NPH] = __builtin_amdgcn_s_memrealtime();
    if (blockIdx.x == 0 && tid == 0) { asm volatile("s_waitcnt vmcnt(0)" ::: "memory"); a.out[0] = (float)(tsv[PROBE_PHASE + 1] - tsv[PROBE_PHASE]) * 0.01f; }
#endif
#undef IN
#undef SEAM
}

extern "C" void kernel_launch(void* const* d_in, const int* in_sizes, int n_in, void* d_out, int out_size, void* d_ws, size_t ws_size, hipStream_t stream) {
    static int grid = 0;
    if (grid == 0) {
        if (n_in != 15 || out_size != M * DM || ws_size < (size_t)496 * MiB) { fprintf(stderr, "kernel_launch: unexpected shapes: n_in %d out %d ws %zu\n", n_in, out_size, ws_size); grid = -1; return; }
        int dev = 0, cus = 0, per_cu = 0;
        (void)hipGetDevice(&dev); (void)hipDeviceGetAttribute(&cus, hipDeviceAttributeMultiprocessorCount, dev);
        if (hipFuncSetAttribute((const void*)fwd_megakernel, hipFuncAttributeMaxDynamicSharedMemorySize, LDS_BYTES) != hipSuccess) { fprintf(stderr, "kernel_launch: hipFuncSetAttribute failed\n"); grid = -1; return; }
        if (hipOccupancyMaxActiveBlocksPerMultiprocessor(&per_cu, (const void*)fwd_megakernel, NTHR, LDS_BYTES) != hipSuccess || per_cu < 1) { fprintf(stderr, "kernel_launch: occupancy query says %d\n", per_cu); per_cu = 1; }
        (void)hipGetLastError();
        grid = cus * 1;
        if (grid <= 0) grid = 256;
    }
    if (grid < 0) return;
    (void)hipMemsetAsync((char*)d_ws + WS_CTL, 0, CTL_ZERO_BYTES, stream);
    Args a{};
    for (int i = 0; i < 15; ++i) a.in[i] = (const float*)d_in[i];
    a.out = (float*)d_out; a.ws = (unsigned char*)d_ws;
#if MK_N_LAUNCHES == 1
    a.ph_lo = 0; a.ph_hi = NPH;
    void* kargs[] = {&a};
    hipError_t e = hipLaunchCooperativeKernel((const void*)fwd_megakernel, dim3(grid), dim3(NTHR), kargs, LDS_BYTES, stream);
    if (e != hipSuccess) fprintf(stderr, "cooperative launch failed: %s (grid %d)\n", hipGetErrorString(e), grid);
#else
    for (int p = 0; p < NPH; ++p) { a.ph_lo = p; a.ph_hi = p + 1; hipLaunchKernelGGL(fwd_megakernel, dim3(grid), dim3(NTHR), LDS_BYTES, stream, a); }
#endif
}
```

```cpp
#include <hip/hip_runtime.h>
#include <hip/hip_cooperative_groups.h>
#include <cstdio>
#include <cstdint>
namespace cg = cooperative_groups;
namespace pg8 {
#define PG8_LAS __attribute__((address_space(3)))
typedef unsigned short bf16_t;
typedef short bf16x8 __attribute__((ext_vector_type(8)));
typedef float f32x4 __attribute__((ext_vector_type(4)));
typedef unsigned u32x4 __attribute__((ext_vector_type(4)));
constexpr int BM = 256, BK = 64, HALF = 128, HTB = HALF * BK * 2  , STAGE_BYTES = 8 * HTB, NXCD = 8, WGM = 8;

__host__ __device__ __forceinline__ int lds_byte(int r, int c) { const int st = (r >> 4) * 2 + (c >> 5), rr = r & 15, cc = c & 31, ob = rr * 64 + cc * 2; return st * 1024 + (ob ^ (((ob >> 9) & 1) << 5)); }
__host__ __device__ __forceinline__ void stage_rc(int b, int& R, int& C) { const int st = b / 1024, sb = b % 1024, swz = sb ^ (((sb >> 9) & 1) << 5); R = (st >> 1) * 16 + swz / 64; C = (st & 1) * 32 + (swz % 64) / 2; }
__host__ __device__ __forceinline__ int perm32(int rho) { const int n = rho >> 4, i = rho & 15; return 8 * (i >> 2) + 4 * n + (i & 3); }

struct Unit { int pm, pn; };
struct Gemm { const bf16_t* A; const bf16_t* Bt; int M, N, K; };

struct StaticOrder {
    int nM, nN, nwg, G, c;
    __host__ __device__ void init(int M, int N, int G_, int c_) { nM = M / BM; nN = N / BM; nwg = nM * nN; G = G_; c = c_; }
    __host__ __device__ bool next(int i, Unit& u) const {
        const long L = (long)i * G + c; if (L >= nwg) return false;
        int wgid = (int)L; { const int q = nwg / NXCD, r = nwg % NXCD, xcd = wgid % NXCD, off = wgid / NXCD; wgid = (xcd < r ? xcd * (q + 1) : r * (q + 1) + (xcd - r) * q) + off; }
        const int nig = WGM * nN, gid = wgid / nig, fm = gid * WGM, gsz = (nM - fm) < WGM ? (nM - fm) : WGM;
        u.pm = fm + ((wgid % nig) % gsz); u.pn = (wgid % nig) / gsz; return true;
    }
    __device__ __forceinline__ void a_ready(const Unit&) const {}
    __device__ __forceinline__ void done(const Unit&) const {}
};

__device__ __forceinline__ unsigned cvt_pk_bf16(float lo, float hi) { unsigned r; asm volatile("v_cvt_pk_bf16_f32 %0, %1, %2" : "=v"(r) : "v"(lo), "v"(hi)); return r; }
typedef float f32x2 __attribute__((ext_vector_type(2)));
template <class Epi, class Sched, bool ALIGN_EPI = false, bool SP2 = false>
__device__ __forceinline__ void gemm_phase(PG8_LAS unsigned char* lds, const Gemm g, const Sched& S, const Epi& E) {
    const int tid = threadIdx.x, wid = __builtin_amdgcn_readfirstlane(tid >> 6), lane = tid & 63, wr = wid >> 2, wc = wid & 3, fr = lane & 15, fq = lane >> 4;
    const int K = g.K, nt = K / BK;
    unsigned voffA[2], voffB[2];
#pragma unroll
    for (int i = 0; i < 2; ++i) { int R, C; stage_rc(tid * 16 + i * 8192, R, C); const int Rb = Epi::PERM ? ((R & ~31) + perm32(R & 31)) : R;
        voffA[i] = (unsigned)(R * K + C) * 2u; voffB[i] = (unsigned)(Rb * K + C) * 2u; }
    const size_t kstep = (size_t)(BK * 2);
    const size_t hstep = (size_t)HALF * K * 2;
    const size_t tstep = 2 * hstep;
    const unsigned ldsw = (unsigned)wid * 1024u;
    const int aoff = lds_byte(wr * 64 + fr, fq * 8), boff = lds_byte(wc * 32 + fr, fq * 8);
#define PG8_SA(b, h) (((b) * 2 + (h)) * HTB)
#define PG8_SB(b, h) ((4 + (b) * 2 + (h)) * HTB)
#define PG8_STAGE(bufoff, gbase, voff) do { _Pragma("unroll") for (int _i = 0; _i < 2; ++_i) \
        __builtin_amdgcn_global_load_lds((const unsigned*)((const char*)(gbase) + (voff)[_i]), (PG8_LAS unsigned*)(lds + (bufoff) + ldsw + _i * 8192), 16, 0, 0); } while (0)
#define PG8_LDA(dst, b, h) do { _Pragma("unroll") for (int m = 0; m < 4; ++m) _Pragma("unroll") for (int k = 0; k < 2; ++k) dst[m][k] = *(const PG8_LAS bf16x8*)(lds + PG8_SA(b, h) + aoff + m * 2048 + k * 1024); } while (0)
#define PG8_LDB(dst, b, h) do { _Pragma("unroll") for (int n = 0; n < 2; ++n) _Pragma("unroll") for (int k = 0; k < 2; ++k) dst[n][k] = *(const PG8_LAS bf16x8*)(lds + PG8_SB(b, h) + boff + n * 2048 + k * 1024); } while (0)
#define PG8_MMA(ai, bj, At, Bt) do { __builtin_amdgcn_s_setprio(1); _Pragma("unroll") for (int m = 0; m < 4; ++m) _Pragma("unroll") for (int n = 0; n < 2; ++n) _Pragma("unroll") for (int k = 0; k < 2; ++k) \
        acc[ai][bj][m][n] = __builtin_amdgcn_mfma_f32_16x16x32_bf16(Bt[n][k], At[m][k], acc[ai][bj][m][n], 0, 0, 0); __builtin_amdgcn_s_setprio(0); } while (0)
#define PG8_WAIT_V(n) asm volatile("s_waitcnt vmcnt(" #n ")" ::: "memory")
#define PG8_WAIT_L(n) asm volatile("s_waitcnt lgkmcnt(" #n ")" ::: "memory")
#define PG8_BAR __builtin_amdgcn_s_barrier()
#define PG8_SCHED __builtin_amdgcn_sched_barrier(0)
    Unit cur, nxt; int ui = 0;
    if (!S.next(0, cur)) return;
    f32x4 acc[2][2][4][2];
#pragma unroll
    for (int a = 0; a < 2; ++a)
#pragma unroll
        for (int b = 0; b < 2; ++b)
#pragma unroll
            for (int m = 0; m < 4; ++m)
#pragma unroll
                for (int n = 0; n < 2; ++n) acc[a][b][m][n] = (f32x4){0.f, 0.f, 0.f, 0.f};
    bf16x8 At[4][2], B0[2][2], B1[2][2];
    const char* cA = (const char*)g.A + (size_t)cur.pm * tstep; const char* cB = (const char*)g.Bt + (size_t)cur.pn * tstep;
    S.a_ready(cur);
    if constexpr (SP2) {
        PG8_STAGE(PG8_SB(0, 0), cB, voffB); PG8_STAGE(PG8_SB(0, 1), cB + hstep, voffB); PG8_STAGE(PG8_SA(0, 0), cA, voffA); PG8_STAGE(PG8_SA(0, 1), cA + hstep, voffA);
        if (wr == 1) PG8_BAR;
        PG8_WAIT_V(2); PG8_BAR;
        PG8_STAGE(PG8_SB(1, 0), cB + kstep, voffB); PG8_STAGE(PG8_SA(1, 0), cA + kstep, voffA); PG8_STAGE(PG8_SB(1, 1), cB + hstep + kstep, voffB);
        PG8_WAIT_V(6); PG8_BAR;
    } else {
        PG8_STAGE(PG8_SB(0, 0), cB, voffB); PG8_STAGE(PG8_SA(0, 0), cA, voffA); PG8_STAGE(PG8_SB(0, 1), cB + hstep, voffB); PG8_STAGE(PG8_SA(0, 1), cA + hstep, voffA);
        if (wr == 1) PG8_BAR;
        PG8_WAIT_V(4); PG8_BAR;
        PG8_STAGE(PG8_SB(1, 0), cB + kstep, voffB); PG8_STAGE(PG8_SA(1, 0), cA + kstep, voffA); PG8_STAGE(PG8_SB(1, 1), cB + hstep + kstep, voffB);
        PG8_WAIT_V(6); PG8_BAR;
    }
    for (;;) {
        const bool has_next = S.next(ui + 1, nxt);
        const char* nA = has_next ? (const char*)g.A + (size_t)nxt.pm * tstep : cA; const char* nB = has_next ? (const char*)g.Bt + (size_t)nxt.pn * tstep : cB;
        for (int t = 0; t < nt; t += 2) {
            const bool last = (t == nt - 2);
            const char* a1 = cA + (size_t)(t + 1) * kstep;
            const char* a2 = last ? nA : cA + (size_t)(t + 2) * kstep; const char* b2 = last ? nB : cB + (size_t)(t + 2) * kstep;
            const char* a3 = a2 + kstep; const char* b3 = b2 + kstep;
            if (last && has_next) S.a_ready(nxt);
            if constexpr (SP2) {
            PG8_LDB(B0, 0, 0); PG8_LDB(B1, 0, 1); PG8_SCHED; PG8_LDA(At, 0, 0); PG8_STAGE(PG8_SA(1, 1), a1 + hstep, voffA);
            PG8_WAIT_V(8); PG8_WAIT_L(0); PG8_BAR; PG8_MMA(0, 0, At, B0); PG8_MMA(0, 1, At, B1); PG8_BAR; PG8_SCHED;
            PG8_LDA(At, 0, 1); PG8_STAGE(PG8_SB(0, 0), b2, voffB); PG8_STAGE(PG8_SB(0, 1), b2 + hstep, voffB); PG8_STAGE(PG8_SA(0, 0), a2, voffA);
            PG8_WAIT_V(8); PG8_WAIT_L(0); PG8_BAR; PG8_MMA(1, 0, At, B0); PG8_MMA(1, 1, At, B1); PG8_BAR; PG8_SCHED;
            PG8_LDB(B0, 1, 0); PG8_LDB(B1, 1, 1); PG8_SCHED; PG8_LDA(At, 1, 0); PG8_STAGE(PG8_SA(0, 1), a2 + hstep, voffA);
            PG8_WAIT_V(8); PG8_WAIT_L(0); PG8_BAR; PG8_MMA(0, 0, At, B0); PG8_MMA(0, 1, At, B1); PG8_BAR; PG8_SCHED;
            PG8_LDA(At, 1, 1); PG8_STAGE(PG8_SB(1, 0), b3, voffB); PG8_STAGE(PG8_SB(1, 1), b3 + hstep, voffB); PG8_STAGE(PG8_SA(1, 0), a3, voffA);
            PG8_WAIT_V(8); PG8_WAIT_L(0); PG8_BAR; PG8_MMA(1, 0, At, B0); PG8_MMA(1, 1, At, B1); PG8_BAR; PG8_SCHED;
            } else {
            PG8_LDB(B0, 0, 0); PG8_SCHED; PG8_LDA(At, 0, 0); PG8_STAGE(PG8_SA(1, 1), a1 + hstep, voffA);
            PG8_WAIT_L(8); PG8_BAR; PG8_WAIT_L(0); PG8_MMA(0, 0, At, B0); PG8_BAR; PG8_SCHED;
            PG8_LDB(B1, 0, 1); PG8_STAGE(PG8_SB(0, 0), b2, voffB);
            PG8_BAR; PG8_WAIT_L(0); PG8_MMA(0, 1, At, B1); PG8_BAR;
            PG8_LDA(At, 0, 1); PG8_STAGE(PG8_SA(0, 0), a2, voffA);
            PG8_BAR; PG8_WAIT_L(0); PG8_MMA(1, 0, At, B0); PG8_BAR; PG8_SCHED;
            PG8_STAGE(PG8_SB(0, 1), b2 + hstep, voffB);
            PG8_WAIT_V(6); PG8_BAR; PG8_MMA(1, 1, At, B1); PG8_BAR;
            PG8_LDB(B0, 1, 0); PG8_SCHED; PG8_LDA(At, 1, 0); PG8_STAGE(PG8_SA(0, 1), a2 + hstep, voffA);
            PG8_WAIT_L(8); PG8_BAR; PG8_WAIT_L(0); PG8_MMA(0, 0, At, B0); PG8_BAR; PG8_SCHED;
            PG8_LDB(B1, 1, 1); PG8_STAGE(PG8_SB(1, 0), b3, voffB);
            PG8_BAR; PG8_WAIT_L(0); PG8_MMA(0, 1, At, B1); PG8_BAR;
            PG8_LDA(At, 1, 1); PG8_STAGE(PG8_SA(1, 0), a3, voffA);
            PG8_BAR; PG8_WAIT_L(0); PG8_MMA(1, 0, At, B0); PG8_BAR; PG8_SCHED;
            PG8_STAGE(PG8_SB(1, 1), b3 + hstep, voffB);
            PG8_WAIT_V(6); PG8_BAR; PG8_MMA(1, 1, At, B1); PG8_BAR;
            }
        }
        if constexpr (ALIGN_EPI) { if (wr == 0) PG8_BAR; }
        bool keep_acc = false;
        if constexpr (!Epi::AFTER_DRAIN) { if constexpr (Epi::CHAIN) keep_acc = E.chain(acc, cur, wr, wc, fr, fq); else E(acc, cur, wr, wc, fr, fq); S.done(cur); }
        if (!has_next) break;
        if (!keep_acc) {
#pragma unroll
        for (int a = 0; a < 2; ++a)
#pragma unroll
            for (int b = 0; b < 2; ++b)
#pragma unroll
                for (int m = 0; m < 4; ++m)
#pragma unroll
                    for (int n = 0; n < 2; ++n) acc[a][b][m][n] = (f32x4){0.f, 0.f, 0.f, 0.f};
        }
        cur = nxt; cA = nA; cB = nB; ++ui;
        if constexpr (ALIGN_EPI) { if (wr == 1) PG8_BAR; }
    }
    PG8_WAIT_V(0);
    if constexpr (!ALIGN_EPI) { if (wr == 0) PG8_BAR; }
    PG8_BAR;
    if constexpr (Epi::AFTER_DRAIN) { E.fused(acc, cur, wr, wc, fr, fq, lds, wid, lane); S.done(cur); }
#undef PG8_SA
#undef PG8_SB
#undef PG8_STAGE
#undef PG8_LDA
#undef PG8_LDB
#undef PG8_MMA
#undef PG8_WAIT_V
#undef PG8_WAIT_L
#undef PG8_BAR
#undef PG8_SCHED
}
}

constexpr int NWAVES = 8, NTHR = 512;
constexpr int BATCH = 16, SEQ = 2048, DM = 1024, NMETA = 16;
constexpr int M = BATCH * SEQ;
constexpr int RH = 8, RDK = 64, RDV = 128;
constexpr int AQH = 16, AKH = 4, ADH = 64;
constexpr int DFF = 2816, INC = 6656;
constexpr float RMS_EPS = 1e-6f, GN_EPS = 1e-5f;
constexpr int NPH = 8;

#define GAS __attribute__((address_space(1)))
#define LAS __attribute__((address_space(3)))
typedef unsigned short bf16;
typedef unsigned v4u __attribute__((ext_vector_type(4)));
typedef unsigned v2u __attribute__((ext_vector_type(2)));
typedef float f32x4 __attribute__((ext_vector_type(4)));
typedef short bf16x8 __attribute__((ext_vector_type(8)));

constexpr size_t MiB = 1u << 20;
constexpr size_t WS_CTL = 0, CTL_ZERO_BYTES = 64 * 1024;
constexpr size_t WS_MKR = 1 * MiB;
constexpr size_t WS_MVR = WS_MKR + 16 * 512 * 2;
constexpr size_t WS_MKA = WS_MVR + 16 * 1024 * 2;
constexpr size_t WS_MVA = WS_MKA + 16 * 256 * 2;
constexpr size_t WS_SSQ1 = 2 * MiB, WS_SSQ2 = 4 * MiB;
constexpr size_t WS_WIN = 6 * MiB, WS_WBR = 19 * MiB, WS_WO = 23 * MiB, WS_WGU = 25 * MiB, WS_WD = 36 * MiB;
constexpr size_t WS_RQ = 48 * MiB, WS_RK = 80 * MiB, WS_RV = 112 * MiB, WS_RG = 176 * MiB, WS_AQ = 240 * MiB, WS_AK = 304 * MiB, WS_AV = 320 * MiB, WS_GA = 336 * MiB, WS_GB = 400 * MiB, WS_END = 464 * MiB;
constexpr size_t WS_XB = WS_RQ;
constexpr size_t WS_ACT = WS_RV;
static_assert(WS_ACT + (size_t)M * DFF * 2 <= WS_AK, "act overlay");

__device__ __forceinline__ unsigned f2bf(float f) { unsigned u = __builtin_bit_cast(unsigned, f); return (u + 0x7fffu + ((u >> 16) & 1u)) >> 16; }
__device__ __forceinline__ unsigned pk2(float lo, float hi) { return f2bf(lo) | (f2bf(hi) << 16); }
__device__ __forceinline__ float bf2f(unsigned short h) { return __builtin_bit_cast(float, (unsigned)h << 16); }
__device__ __forceinline__ float bflo(unsigned w) { return __builtin_bit_cast(float, w << 16); }
__device__ __forceinline__ float bfhi(unsigned w) { return __builtin_bit_cast(float, w & 0xffff0000u); }
__device__ __forceinline__ float wave_sum(float v) {
#pragma unroll
    for (int o = 1; o < 64; o <<= 1) v += __shfl_xor(v, o);
    return v;
}
__device__ __forceinline__ float sigmoidf_(float x) { return __builtin_amdgcn_rcpf(1.0f + __builtin_amdgcn_exp2f(-1.4426950408889634f * x)); }

struct Args { const float* in[15]; float* out; unsigned char* ws; int ph_lo, ph_hi; };

struct Epi1 {
    static constexpr bool PERM = true, AFTER_DRAIN = false, CHAIN = false;
    unsigned char* ws;
    __device__ __forceinline__ void operator()(const pg8::f32x4 (&acc)[2][2][4][2], const pg8::Unit& u, int wr, int wc, int fr, int fq) const {
        const int pn = u.pn; size_t off; int ldc, ct;
        if (pn < 2) { off = WS_RQ; ldc = 512; ct = pn; } else if (pn < 4) { off = WS_RK; ldc = 512; ct = pn - 2; } else if (pn < 8) { off = WS_RV; ldc = 1024; ct = pn - 4; }
        else if (pn < 12) { off = WS_RG; ldc = 1024; ct = pn - 8; } else if (pn < 16) { off = WS_AQ; ldc = 1024; ct = pn - 12; } else if (pn == 16) { off = WS_AK; ldc = 256; ct = 0; }
        else if (pn == 17) { off = WS_AV; ldc = 256; ct = 0; } else if (pn < 22) { off = WS_GA; ldc = 1024; ct = pn - 18; } else { off = WS_GB; ldc = 1024; ct = pn - 22; }
        bf16* base = (bf16*)(ws + off);
        const int row0 = u.pm * 256 + wr * 64 + fr, col0 = ct * 256 + wc * 32 + 8 * fq;
#pragma unroll
        for (int ai = 0; ai < 2; ++ai)
#pragma unroll
            for (int m = 0; m < 4; ++m) { bf16* rowp = base + (size_t)(row0 + ai * 128 + m * 16) * ldc + col0;
#pragma unroll
                for (int bj = 0; bj < 2; ++bj) { const pg8::f32x4 v0 = acc[ai][bj][m][0], v1 = acc[ai][bj][m][1]; v4u w;
                    w.x = pg8::cvt_pk_bf16(v0[0], v0[1]); w.y = pg8::cvt_pk_bf16(v0[2], v0[3]); w.z = pg8::cvt_pk_bf16(v1[0], v1[1]); w.w = pg8::cvt_pk_bf16(v1[2], v1[3]);
                    *(v4u*)(rowp + bj * 128) = w; } }
    }
};
#define EX_(x) __builtin_amdgcn_exp2f(-1.4426950408889634f * (x))
struct Epi3 {
    static constexpr bool PERM = true, AFTER_DRAIN = false, CHAIN = true;
    const bf16* ga; const bf16* gb; bf16* merged;
    __device__ __forceinline__ bool chain(pg8::f32x4 (&acc)[2][2][4][2], const pg8::Unit& u, int wr, int wc, int fr, int fq) const {
        const bool second = u.pm >= 128; const int pm = u.pm & 127, pn = u.pn & 3;
        const int row0 = pm * 256 + wr * 64 + fr, col0 = pn * 256 + wc * 32 + 8 * fq;
#pragma unroll
        for (int ai = 0; ai < 2; ++ai)
#pragma unroll
            for (int m = 0; m < 4; ++m) { const size_t ro = (size_t)(row0 + ai * 128 + m * 16) * 1024 + col0;
#pragma unroll
                for (int bj = 0; bj < 2; ++bj) { const size_t o = ro + bj * 128;
                    const v4u gbv = *(const v4u*)(gb + o);
                    const float eb[8] = {EX_(bflo(gbv.x)), EX_(bfhi(gbv.x)), EX_(bflo(gbv.y)), EX_(bfhi(gbv.y)), EX_(bflo(gbv.z)), EX_(bfhi(gbv.z)), EX_(bflo(gbv.w)), EX_(bfhi(gbv.w))};
                    if (!second) {
                        const v4u gav = *(const v4u*)(ga + o);
                        const float ea[8] = {EX_(bflo(gav.x)), EX_(bfhi(gav.x)), EX_(bflo(gav.y)), EX_(bfhi(gav.y)), EX_(bflo(gav.z)), EX_(bfhi(gav.z)), EX_(bflo(gav.w)), EX_(bfhi(gav.w))};
#pragma unroll
                        for (int j = 0; j < 4; ++j) { acc[ai][bj][m][0][j] *= (1.0f + eb[j]) * __builtin_amdgcn_rcpf(1.0f + ea[j]); acc[ai][bj][m][1][j] *= (1.0f + eb[4 + j]) * __builtin_amdgcn_rcpf(1.0f + ea[4 + j]); }
                    } else {
                        float v[8];
#pragma unroll
                        for (int j = 0; j < 4; ++j) { v[j] = acc[ai][bj][m][0][j] * __builtin_amdgcn_rcpf(1.0f + eb[j]); v[4 + j] = acc[ai][bj][m][1][j] * __builtin_amdgcn_rcpf(1.0f + eb[4 + j]); }
                        v4u w; w.x = pg8::cvt_pk_bf16(v[0], v[1]); w.y = pg8::cvt_pk_bf16(v[2], v[3]); w.z = pg8::cvt_pk_bf16(v[4], v[5]); w.w = pg8::cvt_pk_bf16(v[6], v[7]);
                        *(v4u*)(merged + o) = w;
                    } } }
        return !second;
    }
};
struct Sched3 {
    pg8::StaticOrder S;
    __device__ bool next(int i, pg8::Unit& u) const { if (!S.next(i >> 1, u)) return false; if (i & 1) { u.pm += 128; u.pn += 4; } return true; }
    __device__ __forceinline__ void a_ready(const pg8::Unit&) const {}
    __device__ __forceinline__ void done(const pg8::Unit&) const {}
};
struct Epi4 {
    static constexpr bool PERM = true, AFTER_DRAIN = false, CHAIN = false;
    const float* base; bf16* xb; float* ssq;
    __device__ __forceinline__ void operator()(const pg8::f32x4 (&acc)[2][2][4][2], const pg8::Unit& u, int wr, int wc, int fr, int fq) const {
        const int row0 = u.pm * 256 + wr * 64 + fr, col0 = u.pn * 256 + wc * 32 + 8 * fq;
#pragma unroll
        for (int ai = 0; ai < 2; ++ai)
#pragma unroll
            for (int m = 0; m < 4; ++m) { const int r = row0 + ai * 128 + m * 16; const size_t ro = (size_t)r * 1024 + col0; float ss = 0.f;
#pragma unroll
                for (int bj = 0; bj < 2; ++bj) { const size_t o = ro + bj * 128;
                    const pg8::f32x4 v0 = *(const pg8::f32x4*)(base + o) + acc[ai][bj][m][0], v1 = *(const pg8::f32x4*)(base + o + 4) + acc[ai][bj][m][1];
                    ss += (v0[0] * v0[0] + v0[1] * v0[1]) + (v0[2] * v0[2] + v0[3] * v0[3]) + (v1[0] * v1[0] + v1[1] * v1[1]) + (v1[2] * v1[2] + v1[3] * v1[3]);
                    v4u w; w.x = pg8::cvt_pk_bf16(v0[0], v0[1]); w.y = pg8::cvt_pk_bf16(v0[2], v0[3]); w.z = pg8::cvt_pk_bf16(v1[0], v1[1]); w.w = pg8::cvt_pk_bf16(v1[2], v1[3]); *(v4u*)(xb + o) = w; }
                ss += __shfl_xor(ss, 16); ss += __shfl_xor(ss, 32);
                if (fq == 0) ssq[(size_t)r * 16 + u.pn * 4 + wc] = ss; }
    }
};
struct Epi6 {
    static constexpr bool PERM = true, AFTER_DRAIN = false, CHAIN = false;
    const bf16* xb; float* out; float* ssq;
    __device__ __forceinline__ void operator()(const pg8::f32x4 (&acc)[2][2][4][2], const pg8::Unit& u, int wr, int wc, int fr, int fq) const {
        const int row0 = u.pm * 256 + wr * 64 + fr, col0 = u.pn * 256 + wc * 32 + 8 * fq;
#pragma unroll
        for (int ai = 0; ai < 2; ++ai)
#pragma unroll
            for (int m = 0; m < 4; ++m) { const int r = row0 + ai * 128 + m * 16; const size_t ro = (size_t)r * 1024 + col0; float ss = 0.f;
#pragma unroll
                for (int bj = 0; bj < 2; ++bj) { const size_t o = ro + bj * 128; const v4u b = *(const v4u*)(xb + o);
                    pg8::f32x4 v0 = acc[ai][bj][m][0], v1 = acc[ai][bj][m][1];
                    v0[0] += bflo(b.x); v0[1] += bfhi(b.x); v0[2] += bflo(b.y); v0[3] += bfhi(b.y); v1[0] += bflo(b.z); v1[1] += bfhi(b.z); v1[2] += bflo(b.w); v1[3] += bfhi(b.w);
                    *(pg8::f32x4*)(out + o) = v0; *(pg8::f32x4*)(out + o + 4) = v1;
                    ss += (v0[0] * v0[0] + v0[1] * v0[1]) + (v0[2] * v0[2] + v0[3] * v0[3]) + (v1[0] * v1[0] + v1[1] * v1[1]) + (v1[2] * v1[2] + v1[3] * v1[3]); }
                ss += __shfl_xor(ss, 16); ss += __shfl_xor(ss, 32);
                if (fq == 0) ssq[(size_t)r * 16 + u.pn * 4 + wc] = ss; }
    }
};
struct Epi5 {
    static constexpr bool PERM = true, AFTER_DRAIN = false, CHAIN = false;
    bf16* act; const float* ssq;
    __device__ __forceinline__ void operator()(const pg8::f32x4 (&acc)[2][2][4][2], const pg8::Unit& u, int wr, int wc, int fr, int fq) const {
        const int row0 = u.pm * 256 + wr * 64 + fr, ch0 = u.pn * 128 + wc * 32 + 8 * fq;
#pragma unroll
        for (int ai = 0; ai < 2; ++ai)
#pragma unroll
            for (int m = 0; m < 4; ++m) { const int r = row0 + ai * 128 + m * 16;
                const pg8::f32x4* sp = (const pg8::f32x4*)(ssq + (size_t)r * 16); const pg8::f32x4 s0 = sp[0], s1 = sp[1], s2 = sp[2], s3 = sp[3];
                const float tot = ((s0[0] + s0[1]) + (s0[2] + s0[3])) + ((s1[0] + s1[1]) + (s1[2] + s1[3])) + ((s2[0] + s2[1]) + (s2[2] + s2[3])) + ((s3[0] + s3[1]) + (s3[2] + s3[3]));
                const float rstd = 1.0f / sqrtf(tot * (1.0f / 1024.0f) + RMS_EPS);
                float o[8];
#pragma unroll
                for (int n = 0; n < 2; ++n)
#pragma unroll
                    for (int j = 0; j < 4; ++j) { const float a = acc[ai][0][m][n][j] * rstd, b = acc[ai][1][m][n][j] * rstd; o[n * 4 + j] = a * sigmoidf_(a) * b; }
                v4u w; w.x = pg8::cvt_pk_bf16(o[0], o[1]); w.y = pg8::cvt_pk_bf16(o[2], o[3]); w.z = pg8::cvt_pk_bf16(o[4], o[5]); w.w = pg8::cvt_pk_bf16(o[6], o[7]);
                *(v4u*)(act + (size_t)r * DFF + ch0) = w; }
    }
};

__device__ __forceinline__ void p0_transpose_item(const float* W, int K, int N, bf16* WT, int k0, int n0, int drow0, const float* gk, LAS float* scr, int lane) {
#pragma unroll 8
    for (int i = 0; i < 32; ++i) { const int kk = 2 * i + (lane >> 5); float v = W[(size_t)(k0 + kk) * N + n0 + (lane & 31)]; if (gk) v *= gk[k0 + kk]; scr[kk * 33 + (lane & 31)] = v; }
    asm volatile("s_waitcnt lgkmcnt(0)" ::: "memory");
    const int c = lane & 7;
#pragma unroll
    for (int j = 0; j < 4; ++j) { const int n = (lane >> 3) + 8 * j; const LAS float* s = scr + (8 * c) * 33 + n;
        v4u o; o.x = pk2(s[0 * 33], s[1 * 33]); o.y = pk2(s[2 * 33], s[3 * 33]); o.z = pk2(s[4 * 33], s[5 * 33]); o.w = pk2(s[6 * 33], s[7 * 33]);
        *(v4u*)(WT + (size_t)(drow0 + n) * K + k0 + 8 * c) = o; }
    asm volatile("s_waitcnt lgkmcnt(0)" ::: "memory");
}
__device__ __forceinline__ void p0_prologue(const Args& a, LAS unsigned char* lds, int tid, int lane, int wave, int G) {
    unsigned char* ws = a.ws;
    LAS float* scr = (LAS float*)(lds + wave * 16384);
    const int gw = blockIdx.x * NWAVES + wave, NGW = G * NWAVES;
    constexpr int I_IN = 16 * 208, I_BR = 16 * 32, I_O = 16 * 32, I_GU = 16 * 176, I_D = 44 * 32;
    constexpr int NITEMS = I_IN + 2 * I_BR + I_O + I_GU + I_D;
    for (int it = gw; it < NITEMS; it += NGW) {
        int r = it;
        if (r < I_IN) { const int kb = r / 208, nb = r % 208; p0_transpose_item(a.in[2], 1024, INC, (bf16*)(ws + WS_WIN), 64 * kb, 32 * nb, 32 * nb, nullptr, scr, lane); continue; } r -= I_IN;
        if (r < I_BR) { const int kb = r / 32, nb = r % 32; p0_transpose_item(a.in[7], 1024, 1024, (bf16*)(ws + WS_WBR), 64 * kb, 32 * nb, 32 * nb, nullptr, scr, lane); continue; } r -= I_BR;
        if (r < I_BR) { const int kb = r / 32, nb = r % 32; p0_transpose_item(a.in[8], 1024, 1024, (bf16*)(ws + WS_WBR), 64 * kb, 32 * nb, 1024 + 32 * nb, nullptr, scr, lane); continue; } r -= I_BR;
        if (r < I_O) { const int kb = r / 32, nb = r % 32; p0_transpose_item(a.in[9], 1024, 1024, (bf16*)(ws + WS_WO), 64 * kb, 32 * nb, 32 * nb, nullptr, scr, lane); continue; } r -= I_O;
        if (r < I_GU) { const int kb = r / 176, nb = r % 176; const int n0 = 32 * nb, which = n0 / DFF, ch = n0 % DFF;
            p0_transpose_item(a.in[12], 1024, 2 * DFF, (bf16*)(ws + WS_WGU), 64 * kb, n0, (ch / 128) * 256 + which * 128 + (ch % 128), a.in[11], scr, lane); continue; } r -= I_GU;
        { const int kb = r / 32, nb = r % 32; p0_transpose_item(a.in[13], DFF, 1024, (bf16*)(ws + WS_WD), 64 * kb, 32 * nb, 32 * nb, nullptr, scr, lane); }
    }
    {
        const f32x4* gp = (const f32x4*)a.in[10] + lane; f32x4 g[4];
#pragma unroll
        for (int j = 0; j < 4; ++j) g[j] = gp[64 * j];
        bf16* hb = (bf16*)a.out;
        for (int m = gw; m < M; m += NGW) {
            const f32x4* xr = (const f32x4*)(a.in[0] + (size_t)m * DM) + lane; f32x4 v[4]; float s = 0.f;
#pragma unroll
            for (int j = 0; j < 4; ++j) { v[j] = xr[64 * j]; s += (v[j].x * v[j].x + v[j].y * v[j].y) + (v[j].z * v[j].z + v[j].w * v[j].w); }
            const float rstd = 1.0f / sqrtf(wave_sum(s) * (1.0f / DM) + RMS_EPS);
            v2u* o8 = (v2u*)(hb + (size_t)m * DM) + lane;
#pragma unroll
            for (int j = 0; j < 4; ++j) { v2u o; o.x = pk2(v[j].x * rstd * g[j].x, v[j].y * rstd * g[j].y); o.y = pk2(v[j].z * rstd * g[j].z, v[j].w * rstd * g[j].w); o8[64 * j] = o; }
        }
    }
    if (blockIdx.x < 64) {
        __syncthreads();
        LAS float* hm = (LAS float*)lds;
        LAS float* red = (LAS float*)(lds + 65536);
        {
            const f32x4* gp = (const f32x4*)a.in[10] + lane;
#pragma unroll
            for (int rr = 0; rr < 2; ++rr) { const int r = wave * 2 + rr; const f32x4* xr = (const f32x4*)(a.in[1] + (size_t)r * DM) + lane; f32x4 v[4]; float s = 0.f;
#pragma unroll
                for (int j = 0; j < 4; ++j) { v[j] = xr[64 * j]; s += (v[j].x * v[j].x + v[j].y * v[j].y) + (v[j].z * v[j].z + v[j].w * v[j].w); }
                const float rstd = 1.0f / sqrtf(wave_sum(s) * (1.0f / DM) + RMS_EPS);
#pragma unroll
                for (int j = 0; j < 4; ++j) { const f32x4 g = gp[64 * j]; f32x4 o; o.x = v[j].x * rstd * g.x; o.y = v[j].y * rstd * g.y; o.z = v[j].z * rstd * g.z; o.w = v[j].w * rstd * g.w;
                    *(LAS f32x4*)(hm + r * 1024 + (64 * j + lane) * 4) = o; } }
        }
        __syncthreads();
        const int cgi = blockIdx.x >> 1, chalf = (blockIdx.x & 1) * 32; int src, dcol, ld; size_t dsto;
        if (cgi < 8) { src = 512 + 64 * cgi; dsto = WS_MKR; ld = 512; dcol = 64 * cgi; }
        else if (cgi < 24) { src = 1024 + 64 * (cgi - 8); dsto = WS_MVR; ld = 1024; dcol = 64 * (cgi - 8); }
        else if (cgi < 28) { src = 4096 + 64 * (cgi - 24); dsto = WS_MKA; ld = 256; dcol = 64 * (cgi - 24); }
        else { src = 4352 + 64 * (cgi - 28); dsto = WS_MVA; ld = 256; dcol = 64 * (cgi - 28); }
        float acc[16];
#pragma unroll
        for (int m = 0; m < 16; ++m) acc[m] = 0.f;
        const int col = lane & 31, kh4 = (lane >> 5) * 4;
        const float* wp = a.in[2] + src + chalf + col;
#pragma unroll 4
        for (int it = 0; it < 16; ++it) {
            const int k = 128 * wave + 8 * it + kh4;
            const float w0 = wp[(size_t)k * INC], w1 = wp[(size_t)(k + 1) * INC], w2 = wp[(size_t)(k + 2) * INC], w3 = wp[(size_t)(k + 3) * INC];
#pragma unroll
            for (int m = 0; m < 16; ++m) { const f32x4 hv = *(const LAS f32x4*)(hm + m * 1024 + k); acc[m] += (hv.x * w0 + hv.y * w1) + (hv.z * w2 + hv.w * w3); }
        }
#pragma unroll
        for (int m = 0; m < 16; ++m) { acc[m] += __shfl_xor(acc[m], 32); if (lane < 32) red[(wave * 16 + m) * 32 + col] = acc[m]; }
        __syncthreads();
        {
            const int m = tid >> 5, c = tid & 31; float s = 0.f;
#pragma unroll
            for (int w = 0; w < 8; ++w) s += red[(w * 16 + m) * 32 + c];
            ((bf16*)(ws + dsto))[m * ld + dcol + chalf + c] = (bf16)f2bf(s);
        }
        __syncthreads();
    }
}

__device__ __forceinline__ float log2_sigmoid(float x) { return -log1pf(__expf(-x)) * 1.4426950408889634f; }
__device__ __forceinline__ void naive_retention(const Args& a, int tid, int G) {
    unsigned char* ws = a.ws;
    const bf16* rq = (const bf16*)(ws + WS_RQ); const bf16* rk = (const bf16*)(ws + WS_RK); const bf16* rv = (const bf16*)(ws + WS_RV); bf16* rg = (bf16*)(ws + WS_RG);
    const bf16* mk = (const bf16*)(ws + WS_MKR); const bf16* mv = (const bf16*)(ws + WS_MVR);
    for (int it = blockIdx.x; it < BATCH * RH * 8; it += G) {
        const int b = it / (RH * 8), h = (it / 8) % RH, t = (it % 8) * 256 + (tid >> 1), half = tid & 1;
        const float l2f = log2_sigmoid(a.in[3][h]), l2b = log2_sigmoid(a.in[4][h]);
        const size_t row = (size_t)b * SEQ + t;
        v4u qp[8];
#pragma unroll
        for (int c = 0; c < 8; ++c) qp[c] = *(const v4u*)(rq + row * 512 + h * 64 + c * 8);
        float acc[64];
#pragma unroll
        for (int e = 0; e < 64; ++e) acc[e] = 0.f;
        for (int s = -NMETA; s < SEQ; ++s) {
            const bf16* kp = s < 0 ? mk + (size_t)(s + NMETA) * 512 + h * 64 : rk + ((size_t)b * SEQ + s) * 512 + h * 64;
            const bf16* vp = (s < 0 ? mv + (size_t)(s + NMETA) * 1024 + h * 128 : rv + ((size_t)b * SEQ + s) * 1024 + h * 128) + half * 64;
            float d = 0.f;
#pragma unroll
            for (int c = 0; c < 8; ++c) { const v4u kk = *(const v4u*)(kp + c * 8); const v4u qq = qp[c];
                d += bflo(qq.x) * bflo(kk.x) + bfhi(qq.x) * bfhi(kk.x) + bflo(qq.y) * bflo(kk.y) + bfhi(qq.y) * bfhi(kk.y) + bflo(qq.z) * bflo(kk.z) + bfhi(qq.z) * bfhi(kk.z) + bflo(qq.w) * bflo(kk.w) + bfhi(qq.w) * bfhi(kk.w); }
            const int dist = t - s;
            const float w = d * 0.125f * exp2f(dist >= 0 ? (float)dist * l2f : (float)(-dist) * l2b);
#pragma unroll
            for (int c = 0; c < 8; ++c) { const v4u vv = *(const v4u*)(vp + c * 8);
                acc[c * 8 + 0] += w * bflo(vv.x); acc[c * 8 + 1] += w * bfhi(vv.x); acc[c * 8 + 2] += w * bflo(vv.y); acc[c * 8 + 3] += w * bfhi(vv.y);
                acc[c * 8 + 4] += w * bflo(vv.z); acc[c * 8 + 5] += w * bfhi(vv.z); acc[c * 8 + 6] += w * bflo(vv.w); acc[c * 8 + 7] += w * bfhi(vv.w); }
        }
        float mu = 0.f;
#pragma unroll
        for (int e = 0; e < 64; ++e) mu += acc[e];
        mu += __shfl_xor(mu, 1); mu *= (1.0f / 128.0f); float var = 0.f;
#pragma unroll
        for (int e = 0; e < 64; ++e) { const float dd = acc[e] - mu; var += dd * dd; }
        var += __shfl_xor(var, 1);
        const float rstd = 1.0f / sqrtf(var * (1.0f / 128.0f) + GN_EPS);
        const float* gn = a.in[5] + h * 128 + half * 64;
#pragma unroll
        for (int c = 0; c < 8; ++c) { bf16* gp = rg + row * 1024 + h * 128 + half * 64 + c * 8; const v4u gg = *(const v4u*)gp; float o[8];
            const float gv[8] = {bflo(gg.x), bfhi(gg.x), bflo(gg.y), bfhi(gg.y), bflo(gg.z), bfhi(gg.z), bflo(gg.w), bfhi(gg.w)};
#pragma unroll
            for (int j = 0; j < 8; ++j) o[j] = gv[j] * sigmoidf_(gv[j]) * ((acc[c * 8 + j] - mu) * rstd * gn[c * 8 + j]);
            v4u w4; w4.x = pk2(o[0], o[1]); w4.y = pk2(o[2], o[3]); w4.z = pk2(o[4], o[5]); w4.w = pk2(o[6], o[7]); *(v4u*)gp = w4; }
    }
}
__device__ __forceinline__ void naive_attention(const Args& a, int tid, int G) {
    unsigned char* ws = a.ws;
    bf16* aq = (bf16*)(ws + WS_AQ); const bf16* ak = (const bf16*)(ws + WS_AK); const bf16* av = (const bf16*)(ws + WS_AV);
    const bf16* mk = (const bf16*)(ws + WS_MKA); const bf16* mv = (const bf16*)(ws + WS_MVA);
    for (int it = blockIdx.x; it < BATCH * AQH * 4; it += G) {
        const int b = it / (AQH * 4), qh = (it / 4) % AQH, t = (it % 4) * 512 + tid, kh = qh / 4;
        const float slope = exp2f(-0.5f * (float)(qh + 1));
        const size_t row = (size_t)b * SEQ + t;
        float q[64];
#pragma unroll
        for (int c = 0; c < 8; ++c) { const v4u qq = *(const v4u*)(aq + row * 1024 + qh * 64 + c * 8);
            q[c * 8 + 0] = bflo(qq.x) * 0.125f; q[c * 8 + 1] = bfhi(qq.x) * 0.125f; q[c * 8 + 2] = bflo(qq.y) * 0.125f; q[c * 8 + 3] = bfhi(qq.y) * 0.125f;
            q[c * 8 + 4] = bflo(qq.z) * 0.125f; q[c * 8 + 5] = bfhi(qq.z) * 0.125f; q[c * 8 + 6] = bflo(qq.w) * 0.125f; q[c * 8 + 7] = bfhi(qq.w) * 0.125f; }
        float mx = a.in[6][qh], l = 1.0f, acc[64];
#pragma unroll
        for (int e = 0; e < 64; ++e) acc[e] = 0.f;
        for (int j = -NMETA; j <= 256; ++j) {
            const int s = t - 128 + j;
            if (j >= 0 && (s < 0 || s >= SEQ)) continue;
            const bf16* kp = j < 0 ? mk + (size_t)(j + NMETA) * 256 + kh * 64 : ak + ((size_t)b * SEQ + s) * 256 + kh * 64;
            const bf16* vp = j < 0 ? mv + (size_t)(j + NMETA) * 256 + kh * 64 : av + ((size_t)b * SEQ + s) * 256 + kh * 64;
            float d = 0.f;
#pragma unroll
            for (int c = 0; c < 8; ++c) { const v4u kk = *(const v4u*)(kp + c * 8);
                d += q[c * 8 + 0] * bflo(kk.x) + q[c * 8 + 1] * bfhi(kk.x) + q[c * 8 + 2] * bflo(kk.y) + q[c * 8 + 3] * bfhi(kk.y) + q[c * 8 + 4] * bflo(kk.z) + q[c * 8 + 5] * bfhi(kk.z) + q[c * 8 + 6] * bflo(kk.w) + q[c * 8 + 7] * bfhi(kk.w); }
            if (j >= 0) { const int dist = j < 128 ? 128 - j : j - 128; d -= slope * (float)dist; }
            const float mn = fmaxf(mx, d), f = __expf(mx - mn), p = __expf(d - mn); mx = mn; l = l * f + p;
#pragma unroll
            for (int c = 0; c < 8; ++c) { const v4u vv = *(const v4u*)(vp + c * 8);
                acc[c * 8 + 0] = acc[c * 8 + 0] * f + p * bflo(vv.x); acc[c * 8 + 1] = acc[c * 8 + 1] * f + p * bfhi(vv.x); acc[c * 8 + 2] = acc[c * 8 + 2] * f + p * bflo(vv.y); acc[c * 8 + 3] = acc[c * 8 + 3] * f + p * bfhi(vv.y);
                acc[c * 8 + 4] = acc[c * 8 + 4] * f + p * bflo(vv.z); acc[c * 8 + 5] = acc[c * 8 + 5] * f + p * bfhi(vv.z); acc[c * 8 + 6] = acc[c * 8 + 6] * f + p * bflo(vv.w); acc[c * 8 + 7] = acc[c * 8 + 7] * f + p * bfhi(vv.w); }
        }
        const float il = 1.0f / l;
#pragma unroll
        for (int c = 0; c < 8; ++c) { v4u w4; w4.x = pk2(acc[c * 8 + 0] * il, acc[c * 8 + 1] * il); w4.y = pk2(acc[c * 8 + 2] * il, acc[c * 8 + 3] * il); w4.z = pk2(acc[c * 8 + 4] * il, acc[c * 8 + 5] * il); w4.w = pk2(acc[c * 8 + 6] * il, acc[c * 8 + 7] * il);
            *(v4u*)(aq + row * 1024 + qh * 64 + c * 8) = w4; }
    }
}

typedef float f32x16 __attribute__((ext_vector_type(16)));
typedef float f32x2_t __attribute__((ext_vector_type(2)));
typedef __bf16 bf16x2_t __attribute__((ext_vector_type(2)));
__device__ __forceinline__ unsigned cvtpk(float lo, float hi) { f32x2_t v = {lo, hi}; bf16x2_t b = __builtin_convertvector(v, bf16x2_t); return __builtin_bit_cast(unsigned, b); }
__device__ __forceinline__ bf16x8 pack8(const f32x16& x, int s) { v4u p; p.x = cvtpk(x[8 * s], x[8 * s + 1]); p.y = cvtpk(x[8 * s + 2], x[8 * s + 3]); p.z = cvtpk(x[8 * s + 4], x[8 * s + 5]); p.w = cvtpk(x[8 * s + 6], x[8 * s + 7]); return __builtin_bit_cast(bf16x8, p); }
__device__ __forceinline__ int crow(int reg, int h) { return (reg & 3) + 8 * (reg >> 2) + 4 * h; }
__device__ __forceinline__ int perm16(int x) { return (x & 3) | ((x & 4) << 1) | ((x & 8) >> 1); }
#define MFMA32(a, b, c) __builtin_amdgcn_mfma_f32_32x32x16_bf16((a), (b), (c), 0, 0, 0)
constexpr int AT_KROW = 144, AT_VROW = 848, AT_KIMG = 0, AT_VT = 416 * AT_KROW;
static_assert(AT_VT + 64 * AT_VROW <= 131072, "attention LDS");

template <int MODE> __device__ __forceinline__ void attn_chunk(const LAS unsigned char* lds, int rowbase, int cc, int r, int h, const bf16x8 (&qf)[4], float slope2, float& m, float& l, f32x16& o0, f32x16& o1) {
    f32x16 s;
    if (MODE == 0) {
#pragma unroll
        for (int i = 0; i < 16; ++i) s[i] = i < 8 ? -m : -INFINITY;
    } else {
        const float dq0 = (float)(32 * cc + 4 * h - 128 - r);
#pragma unroll
        for (int i = 0; i < 16; ++i) { const float dq = fabsf(dq0 + (float)((i & 3) + 8 * (i >> 2))); float t = -slope2 * dq - m; if (MODE == 2) t = dq > 128.0f ? -INFINITY : t; s[i] = t; }
    }
    const LAS unsigned char* kp = lds + AT_KIMG + (rowbase + r) * AT_KROW + 16 * h;
#pragma unroll
    for (int ds = 0; ds < 4; ++ds) s = MFMA32(*(const LAS bf16x8*)(kp + 32 * ds), qf[ds], s);
    float mc = s[0];
#pragma unroll
    for (int i = 1; i < (MODE == 0 ? 8 : 16); ++i) mc = fmaxf(mc, s[i]);
    mc = fmaxf(mc, __shfl_xor(mc, 32));
    if (__any(mc > 0.f)) {
        const float dl = fmaxf(mc, 0.f), al = __builtin_amdgcn_exp2f(-dl); m += dl; l *= al;
#pragma unroll
        for (int i = 0; i < 16; ++i) { s[i] -= dl; o0[i] *= al; o1[i] *= al; }
    }
    float ls = 0.f;
#pragma unroll
    for (int i = 0; i < 16; ++i) { s[i] = __builtin_amdgcn_exp2f(s[i]); ls += s[i]; }
    l += ls;
    const LAS unsigned char* vp = lds + AT_VT + r * AT_VROW + (rowbase + 8 * h) * 2;
    { const bf16x8 pk = pack8(s, 0); o0 = MFMA32(*(const LAS bf16x8*)(vp), pk, o0); o1 = MFMA32(*(const LAS bf16x8*)(vp + 32 * AT_VROW), pk, o1); }
    if (MODE != 0) { const bf16x8 pk = pack8(s, 1); o0 = MFMA32(*(const LAS bf16x8*)(vp + 32), pk, o0); o1 = MFMA32(*(const LAS bf16x8*)(vp + 32 * AT_VROW + 32), pk, o1); }
}

__device__ __forceinline__ void attn_unit(const Args& a, LAS unsigned char* lds, int unit, int tid, int lane, int wave, bf16* attbase) {
    unsigned char* ws = a.ws;
    bf16* aq = (bf16*)(ws + WS_AQ); const bf16* ak = (const bf16*)(ws + WS_AK); const bf16* av = (const bf16*)(ws + WS_AV);
    const bf16* mk = (const bf16*)(ws + WS_MKA); const bf16* mv = (const bf16*)(ws + WS_MVA);
    const int n = unit & 15, kh = (unit >> 4) & 3, b = unit >> 6;
    const size_t rowb = (size_t)b * SEQ;
    for (int i = tid; i < 400 * 8; i += NTHR) {
        const int row = i >> 3, pc = i & 7; const bf16* src; int irow;
        if (row < 16) { src = mk + (size_t)row * 256 + kh * 64 + pc * 8; irow = row; }
        else { const int j = row - 16, t = 128 * (n - 1) + j; if (t < 0 || t >= SEQ) continue; src = ak + (rowb + t) * 256 + kh * 64 + pc * 8; irow = 32 + j; }
        *(LAS v4u*)(lds + AT_KIMG + irow * AT_KROW + pc * 16) = *(const v4u*)src;
    }
    if (tid < 16 * 8) *(LAS v4u*)(lds + AT_KIMG + (16 + (tid >> 3)) * AT_KROW + (tid & 7) * 16) = (v4u){0u, 0u, 0u, 0u};
    for (int i = tid; i < 200 * 8; i += NTHR) {
        const int pr = i >> 3, pc = i & 7; const bf16* src; int pos;
        if (pr < 8) { src = mv + (size_t)(2 * pr) * 256 + kh * 64 + pc * 8; pos = perm16(2 * pr); }
        else { const int j = 2 * (pr - 8), t = 128 * (n - 1) + j; if (t < 0 || t >= SEQ) continue; src = av + (rowb + t) * 256 + kh * 64 + pc * 8; pos = 32 + (j & ~15) + perm16(j & 15); }
        const v4u v0 = *(const v4u*)src, v1 = *(const v4u*)(src + 256);
        LAS unsigned char* dst = lds + AT_VT + (pc * 8) * AT_VROW + pos * 2;
        *(LAS unsigned*)(dst + 0 * AT_VROW) = (v0.x & 0xffffu) | (v1.x << 16); *(LAS unsigned*)(dst + 1 * AT_VROW) = (v0.x >> 16) | (v1.x & 0xffff0000u);
        *(LAS unsigned*)(dst + 2 * AT_VROW) = (v0.y & 0xffffu) | (v1.y << 16); *(LAS unsigned*)(dst + 3 * AT_VROW) = (v0.y >> 16) | (v1.y & 0xffff0000u);
        *(LAS unsigned*)(dst + 4 * AT_VROW) = (v0.z & 0xffffu) | (v1.z << 16); *(LAS unsigned*)(dst + 5 * AT_VROW) = (v0.z >> 16) | (v1.z & 0xffff0000u);
        *(LAS unsigned*)(dst + 6 * AT_VROW) = (v0.w & 0xffffu) | (v1.w << 16); *(LAS unsigned*)(dst + 7 * AT_VROW) = (v0.w >> 16) | (v1.w & 0xffff0000u);
    }
    __syncthreads();
    const int r = lane & 31, h = lane >> 5;
    constexpr float L2E = 1.4426950408889634f;
#pragma unroll 1
    for (int rep = 0; rep < 2; ++rep) {
        const int tt = wave + 8 * rep, g = tt >> 2, p = tt & 3, qh = kh * 4 + g;
        const size_t qrow = rowb + 128 * n + 32 * p + r;
        bf16* qp = aq + qrow * 1024 + qh * 64; bf16* op = attbase + qrow * 1024 + qh * 64;
        bf16x8 qf[4];
        constexpr float QSC = 0.125f * L2E;
#pragma unroll
        for (int ds = 0; ds < 4; ++ds) { const v4u q = *(const v4u*)(qp + 16 * ds + 8 * h); v4u w;
            w.x = cvtpk(bflo(q.x) * QSC, bfhi(q.x) * QSC); w.y = cvtpk(bflo(q.y) * QSC, bfhi(q.y) * QSC); w.z = cvtpk(bflo(q.z) * QSC, bfhi(q.z) * QSC); w.w = cvtpk(bflo(q.w) * QSC, bfhi(q.w) * QSC);
            qf[ds] = __builtin_bit_cast(bf16x8, w); }
        const float slope2 = exp2f(-0.5f * (float)(qh + 1)) * L2E;
        float m = a.in[6][qh] * L2E, l = h == 0 ? 1.0f : 0.0f;
        f32x16 o0, o1;
#pragma unroll
        for (int i = 0; i < 16; ++i) { o0[i] = 0.f; o1[i] = 0.f; }
        attn_chunk<0>(lds, 0, -1, r, h, qf, slope2, m, l, o0, o1);
        { const int blk = n - 1 + (p >> 2); if (blk >= 0) attn_chunk<2>(lds, 32 + 32 * p, 0, r, h, qf, slope2, m, l, o0, o1); }
#pragma unroll 1
        for (int cc = 1; cc < 8; ++cc) {
            const int cj = p + cc, blk = n - 1 + (cj >> 2);
            if (blk < 0 || blk > 15) continue;
            attn_chunk<1>(lds, 32 + 32 * cj, cc, r, h, qf, slope2, m, l, o0, o1);
        }
        { const int blk = n - 1 + ((p + 8) >> 2); if (blk <= 15) attn_chunk<2>(lds, 32 + 32 * (p + 8), 8, r, h, qf, slope2, m, l, o0, o1); }
        l += __shfl_xor(l, 32);
        const float il = 1.0f / l;
#pragma unroll
        for (int gq = 0; gq < 4; ++gq) {
            v2u w0, w1;
            w0.x = cvtpk(o0[4 * gq] * il, o0[4 * gq + 1] * il); w0.y = cvtpk(o0[4 * gq + 2] * il, o0[4 * gq + 3] * il);
            w1.x = cvtpk(o1[4 * gq] * il, o1[4 * gq + 1] * il); w1.y = cvtpk(o1[4 * gq + 2] * il, o1[4 * gq + 3] * il);
            *(v2u*)(op + 8 * gq + 4 * h) = w0; *(v2u*)(op + 32 + 8 * gq + 4 * h) = w1;
        }
    }
    __syncthreads();
}
__device__ __forceinline__ void attn_phase(const Args& a, LAS unsigned char* lds, int tid, int lane, int wave, int G, bf16* attbase) {
    for (int u = blockIdx.x; u < BATCH * AKH * 16; u += G) attn_unit(a, lds, u, tid, lane, wave, attbase);
}

constexpr size_t WS_SB = 464 * MiB;
constexpr int RT_ROWK = 144, RT_ROWT = 272;
constexpr int RT_KIMG = 0, RT_KT = RT_KIMG + 128 * RT_ROWK, RT_VT = RT_KT + 64 * RT_ROWT, RT_STF = RT_VT + 128 * RT_ROWT, RT_STB = RT_STF + 128 * RT_ROWK, RT_XCH = RT_STB + 128 * RT_ROWK, RT_GN = RT_XCH + 2048, RT_END = RT_GN + 512;
static_assert(RT_END <= 131072, "retention LDS");

__device__ __forceinline__ void rt_put_t(LAS unsigned char* img, int j0, int c0, v4u r0, v4u r1, float s0, float s1, bool scale) {
    const int pos = (j0 & ~15) + perm16(j0 & 15);
    LAS unsigned char* dst = img + c0 * RT_ROWT + pos * 2;
    const unsigned a[4] = {r0.x, r0.y, r0.z, r0.w}, bq[4] = {r1.x, r1.y, r1.z, r1.w};
#pragma unroll
    for (int q = 0; q < 4; ++q) {
        unsigned lo, hi;
        if (scale) { lo = cvtpk(bflo(a[q]) * s0, bflo(bq[q]) * s1); hi = cvtpk(bfhi(a[q]) * s0, bfhi(bq[q]) * s1); }
        else { lo = (a[q] & 0xffffu) | (bq[q] << 16); hi = (a[q] >> 16) | (bq[q] & 0xffff0000u); }
        *(LAS unsigned*)(dst + (2 * q) * RT_ROWT) = lo; *(LAS unsigned*)(dst + (2 * q + 1) * RT_ROWT) = hi;
    }
}
__device__ __forceinline__ void rt_tile_to_img(LAS unsigned char* img, const f32x16& t, int eb, int db, int r, int h) {
#pragma unroll
    for (int i = 0; i < 16; ++i) *(LAS unsigned short*)(img + (32 * eb + crow(i, h)) * RT_ROWK + (32 * db + r) * 2) = (unsigned short)f2bf(t[i]);
}

__device__ __forceinline__ void rt_tile_to_global(bf16* img, const f32x16& t, int eb, int db, int r, int h) {
#pragma unroll
    for (int i = 0; i < 16; ++i) img[(32 * eb + crow(i, h)) * 64 + 32 * db + r] = (bf16)f2bf(t[i]);
}
constexpr int R1_SET = 53248, R1_KT = 0, R1_VT = 17408;
static_assert(2 * R1_SET <= 131072 && R1_VT + 128 * RT_ROWT <= R1_SET, "retention pass-1 LDS");

__device__ __forceinline__ void ret_unit(const Args& a, LAS unsigned char* lds, int unit, int tid_, int lane_, int wave, bf16* retbase) {
    const int tid = tid_, lane = lane_;
    unsigned char* ws = a.ws;
    const int b = unit >> 3, hd = unit & 7;
    const size_t rowb = (size_t)b * SEQ;
    const bf16* rq = (const bf16*)(ws + WS_RQ) + hd * 64; const bf16* rk = (const bf16*)(ws + WS_RK) + hd * 64; const bf16* rv = (const bf16*)(ws + WS_RV) + hd * 128; const bf16* rg = (const bf16*)(ws + WS_RG) + hd * 128;
    const bf16* mk = (const bf16*)(ws + WS_MKR) + hd * 64; const bf16* mv = (const bf16*)(ws + WS_MVR) + hd * 128;
    bf16* sbg = (bf16*)(ws + WS_SB) + (size_t)unit * 16 * 8192;
    const float l2f = log2_sigmoid(a.in[3][hd]), l2b = log2_sigmoid(a.in[4][hd]);
    const float cdf = exp2f(128.0f * l2f), cdb = exp2f(128.0f * l2b);
    const int r = lane & 31, h = lane >> 5;
    const int pj0 = 2 * (tid >> 3), pc = tid & 7;
    const float kb0 = exp2f(l2b * (float)pj0 - 3.0f), kb1 = exp2f(l2b * (float)(pj0 + 1) - 3.0f);
    const int eb_s = wave >> 1, db_s = wave & 1;
    f32x16 tile;
    v4u pk0, pk1, pv0, pv1, pv2, pv3;
    const unsigned kofs = (unsigned)(pj0 * 512 + pc * 8), vofs = (unsigned)(pj0 * 1024 + pc * 8);
#define RT_LOAD_K(c) do { const bf16* kp_ = rk + (rowb + 128 * (c)) * 512; pk0 = *(const v4u*)(kp_ + kofs); pk1 = *(const v4u*)(kp_ + kofs + 512); } while (0)
#define RT_LOAD_V(c) do { const bf16* vp_ = rv + (rowb + 128 * (c)) * 1024; pv0 = *(const v4u*)(vp_ + vofs); pv1 = *(const v4u*)(vp_ + vofs + 1024); pv2 = *(const v4u*)(vp_ + vofs + 64); pv3 = *(const v4u*)(vp_ + vofs + 1024 + 64); } while (0)
#define RT_LOAD_KV(c) do { RT_LOAD_K(c); RT_LOAD_V(c); } while (0)
#pragma unroll
    for (int i = 0; i < 16; ++i) tile[i] = 0.f;
    RT_LOAD_KV(15);
    { LAS unsigned char* S_ = lds + (15 & 1) * R1_SET; rt_put_t(S_ + R1_KT, pj0, pc * 8, pk0, pk1, kb0, kb1, true); rt_put_t(S_ + R1_VT, pj0, pc * 8, pv0, pv1, 0.f, 0.f, false); rt_put_t(S_ + R1_VT, pj0, pc * 8 + 64, pv2, pv3, 0.f, 0.f, false); }
    RT_LOAD_KV(14);
    __syncthreads();
#pragma unroll 1
    for (int c = 15; c >= 1; --c) {
        rt_tile_to_global(sbg + (size_t)c * 8192, tile, eb_s, db_s, r, h);
        if (c >= 2) { LAS unsigned char* S_ = lds + ((c - 1) & 1) * R1_SET; rt_put_t(S_ + R1_KT, pj0, pc * 8, pk0, pk1, kb0, kb1, true); rt_put_t(S_ + R1_VT, pj0, pc * 8, pv0, pv1, 0.f, 0.f, false); rt_put_t(S_ + R1_VT, pj0, pc * 8 + 64, pv2, pv3, 0.f, 0.f, false); }
        if (c >= 3) RT_LOAD_KV(c - 2);
        const LAS unsigned char* vtA = lds + (c & 1) * R1_SET + R1_VT + (32 * eb_s + r) * RT_ROWT + 16 * h;
        const LAS unsigned char* ktB = lds + (c & 1) * R1_SET + R1_KT + (32 * db_s + r) * RT_ROWT + 16 * h;
#pragma unroll
        for (int i = 0; i < 16; ++i) tile[i] *= cdb;
#pragma unroll
        for (int s = 0; s < 8; ++s) tile = MFMA32(*(const LAS bf16x8*)(vtA + 32 * s), *(const LAS bf16x8*)(ktB + 32 * s), tile);
        __syncthreads();
    }
    rt_tile_to_global(sbg, tile, eb_s, db_s, r, h);
    int tid_o = tid_; asm volatile("" : "+v"(tid_o));
    {
    const int tid = tid_o, lane = tid & 63, r = lane & 31, h = lane >> 5;
    const int pj0 = 2 * (tid >> 3), pc = tid & 7;
    const float kf0 = exp2f(l2f * (float)(127 - pj0) - 3.0f), kf1 = exp2f(l2f * (float)(126 - pj0) - 3.0f);
    const unsigned kofs = (unsigned)(pj0 * 512 + pc * 8), vofs = (unsigned)(pj0 * 1024 + pc * 8);
    const LAS unsigned char* vtA = lds + RT_VT + (32 * eb_s + r) * RT_ROWT + 16 * h;
    const LAS unsigned char* ktB = lds + RT_KT + (32 * db_s + r) * RT_ROWT + 16 * h;
#pragma unroll
    for (int i = 0; i < 16; ++i) tile[i] = 0.f;
    {
        v4u k0 = {0u, 0u, 0u, 0u}, k1 = k0, v0 = k0, v1 = k0, v2 = k0, v3 = k0;
        if (pj0 >= 112) { const bf16* kp = mk + (size_t)(pj0 - 112) * 512 + pc * 8; k0 = *(const v4u*)kp; k1 = *(const v4u*)(kp + 512);
            const bf16* vp = mv + (size_t)(pj0 - 112) * 1024 + pc * 8; v0 = *(const v4u*)vp; v1 = *(const v4u*)(vp + 1024); v2 = *(const v4u*)(vp + 64); v3 = *(const v4u*)(vp + 1024 + 64); }
        RT_LOAD_KV(0);
        rt_put_t(lds + RT_KT, pj0, pc * 8, k0, k1, kf0, kf1, true);
        rt_put_t(lds + RT_VT, pj0, pc * 8, v0, v1, 0.f, 0.f, false); rt_put_t(lds + RT_VT, pj0, pc * 8 + 64, v2, v3, 0.f, 0.f, false);
        __syncthreads();
#pragma unroll
        for (int s = 0; s < 8; ++s) tile = MFMA32(*(const LAS bf16x8*)(vtA + 32 * s), *(const LAS bf16x8*)(ktB + 32 * s), tile);
        __syncthreads();
    }
    const int qt = wave & 3, eh = wave >> 2;
    const float cf = exp2f(l2f * (float)(32 * qt + r + 1)), cb = exp2f(l2b * (float)(128 - 32 * qt - r));
    v4u ps0, ps1;
    bf16x8 qf[4];
    if (tid < 128) ((LAS float*)(lds + RT_GN))[tid] = a.in[5][hd * 128 + tid];
    asm volatile("s_waitcnt vmcnt(0)" ::: "memory"); __syncthreads();
    const unsigned sofs = (unsigned)((tid >> 3) * 64 + (tid & 7) * 8), qofs = (unsigned)((32 * qt + r) * 512 + 8 * h), gofs = (unsigned)((32 * qt + r) * 1024 + 64 * eh + 4 * h);
#define RT_LOAD_SB(c) do { const bf16* sp_ = sbg + (size_t)(c) * 8192; ps0 = *(const v4u*)(sp_ + sofs); ps1 = *(const v4u*)(sp_ + sofs + 4096); } while (0)
#define RT_LOAD_Q(dst, c) do { const bf16* qp_ = rq + (rowb + 128 * (c)) * 512; _Pragma("unroll") for (int ds = 0; ds < 4; ++ds) dst[ds] = *(const bf16x8*)(qp_ + qofs + 16 * ds); } while (0)
    RT_LOAD_SB(0); RT_LOAD_Q(qf, 0);
#pragma unroll 1
    for (int c = 0; c < 16; ++c) {
        rt_tile_to_img(lds + RT_STF, tile, eb_s, db_s, r, h);
        *(LAS v4u*)(lds + RT_KIMG + pj0 * RT_ROWK + pc * 16) = pk0; *(LAS v4u*)(lds + RT_KIMG + (pj0 + 1) * RT_ROWK + pc * 16) = pk1;
        rt_put_t(lds + RT_KT, pj0, pc * 8, pk0, pk1, kf0, kf1, true);
        rt_put_t(lds + RT_VT, pj0, pc * 8, pv0, pv1, 0.f, 0.f, false); rt_put_t(lds + RT_VT, pj0, pc * 8 + 64, pv2, pv3, 0.f, 0.f, false);
        *(LAS v4u*)(lds + RT_STB + (tid >> 3) * RT_ROWK + (tid & 7) * 16) = ps0; *(LAS v4u*)(lds + RT_STB + (64 + (tid >> 3)) * RT_ROWK + (tid & 7) * 16) = ps1;
        __syncthreads();
        const bf16* rg_c = rg + (rowb + 128 * c) * 1024; bf16* op_c = retbase + hd * 128 + (rowb + 128 * c) * 1024;
        bf16x8 pk[4][2];
#pragma unroll
        for (int kc = 0; kc < 4; ++kc) {
            f32x16 s;
#pragma unroll
            for (int i = 0; i < 16; ++i) s[i] = 0.f;
            const LAS unsigned char* kp = lds + RT_KIMG + (32 * kc + r) * RT_ROWK + 16 * h;
#pragma unroll
            for (int ds = 0; ds < 4; ++ds) s = MFMA32(*(const LAS bf16x8*)(kp + 32 * ds), qf[ds], s);
            float d0 = (float)(32 * qt + r - 32 * kc - 4 * h); asm volatile("" : "+v"(d0));
#pragma unroll
            for (int i = 0; i < 16; ++i) { const float df = d0 - (float)((i & 3) + 8 * (i >> 2)); s[i] *= __builtin_amdgcn_exp2f(fminf(l2f * df, -l2b * df) - 3.0f); }
            pk[kc][0] = pack8(s, 0); pk[kc][1] = pack8(s, 1);
            __builtin_amdgcn_sched_barrier(0);
        }
        f32x16 o[2];
#pragma unroll
        for (int e2 = 0; e2 < 2; ++e2) {
            const int eb = 2 * eh + e2;
            f32x16 acc, xf, xb;
#pragma unroll
            for (int i = 0; i < 16; ++i) { acc[i] = 0.f; xf[i] = 0.f; xb[i] = 0.f; }
            const LAS unsigned char* vp = lds + RT_VT + (32 * eb + r) * RT_ROWT + 16 * h;
#pragma unroll
            for (int kc = 0; kc < 4; ++kc) { acc = MFMA32(*(const LAS bf16x8*)(vp + 64 * kc), pk[kc][0], acc); acc = MFMA32(*(const LAS bf16x8*)(vp + 64 * kc + 32), pk[kc][1], acc); }
            const LAS unsigned char* fp = lds + RT_STF + (32 * eb + r) * RT_ROWK + 16 * h; const LAS unsigned char* bp = lds + RT_STB + (32 * eb + r) * RT_ROWK + 16 * h;
#pragma unroll
            for (int ds = 0; ds < 4; ++ds) { xf = MFMA32(*(const LAS bf16x8*)(fp + 32 * ds), qf[ds], xf); xb = MFMA32(*(const LAS bf16x8*)(bp + 32 * ds), qf[ds], xb); }
#pragma unroll
            for (int i = 0; i < 16; ++i) o[e2][i] = acc[i] + cf * xf[i] + cb * xb[i];
            __builtin_amdgcn_sched_barrier(0);
        }
        float s1 = 0.f, s2 = 0.f;
#pragma unroll
        for (int e2 = 0; e2 < 2; ++e2)
#pragma unroll
            for (int i = 0; i < 16; ++i) { s1 += o[e2][i]; s2 += o[e2][i] * o[e2][i]; }
        s1 += __shfl_xor(s1, 32); s2 += __shfl_xor(s2, 32);
        LAS float* xch = (LAS float*)(lds + RT_XCH);
        if (h == 0) { xch[(eh * 128 + 32 * qt + r) * 2] = s1; xch[(eh * 128 + 32 * qt + r) * 2 + 1] = s2; }
        __builtin_amdgcn_sched_barrier(0);
#pragma unroll
        for (int i = 0; i < 16; ++i) tile[i] *= cdf;
#pragma unroll
        for (int s = 0; s < 8; ++s) tile = MFMA32(*(const LAS bf16x8*)(vtA + 32 * s), *(const LAS bf16x8*)(ktB + 32 * s), tile);
        __syncthreads();
        if (c < 15) { RT_LOAD_K(c + 1); RT_LOAD_SB(c + 1); RT_LOAD_V(c + 1); RT_LOAD_Q(qf, c + 1); }
        __builtin_amdgcn_sched_barrier(0);
        {
            const float p1 = xch[((eh ^ 1) * 128 + 32 * qt + r) * 2], p2 = xch[((eh ^ 1) * 128 + 32 * qt + r) * 2 + 1];
            const float mu = (s1 + p1) * (1.0f / 128.0f), var = (s2 + p2) * (1.0f / 128.0f) - mu * mu, rstd = 1.0f / sqrtf(fmaxf(var, 0.f) + GN_EPS);
            const LAS float* gn = (const LAS float*)(lds + RT_GN) + 64 * eh + 4 * h;
#pragma unroll
            for (int e2 = 0; e2 < 2; ++e2)
#pragma unroll
                for (int gq = 0; gq < 4; ++gq) { const int e0 = 32 * e2 + 8 * gq; const v2u g2 = *(const v2u*)(rg_c + gofs + e0); const f32x4 gv = *(const LAS f32x4*)(gn + e0);
                    const float g0 = bflo(g2.x), g1 = bfhi(g2.x), g2f = bflo(g2.y), g3 = bfhi(g2.y);
                    v2u w; w.x = cvtpk(g0 * sigmoidf_(g0) * ((o[e2][4 * gq] - mu) * rstd * gv.x), g1 * sigmoidf_(g1) * ((o[e2][4 * gq + 1] - mu) * rstd * gv.y));
                    w.y = cvtpk(g2f * sigmoidf_(g2f) * ((o[e2][4 * gq + 2] - mu) * rstd * gv.z), g3 * sigmoidf_(g3) * ((o[e2][4 * gq + 3] - mu) * rstd * gv.w));
                    *(v2u*)(op_c + gofs + e0) = w; }
        }
    }
    }
#undef RT_LOAD_KV
#undef RT_LOAD_K
#undef RT_LOAD_V
#undef RT_LOAD_SB
#undef RT_LOAD_Q
    __syncthreads();
}

#define XB_TMO      128
#define XB_XCNT(j)  (256  + 64 * (j))
#define XB_XSUB(j)  (1280 + 64 * (j))
#define XB_XGEN(j)  (2304 + 64 * (j))
#define XB_TOP      3328
#define XB_TOPGEN   3392
#define XCD_BAR_WORDS 3456
#define XB_SPIN_CAP (1u << 18)

__device__ __forceinline__ unsigned xb_ld(unsigned* p)              { return __hip_atomic_load(p, __ATOMIC_RELAXED, __HIP_MEMORY_SCOPE_AGENT); }
__device__ __forceinline__ unsigned xb_add(unsigned* p, unsigned v) { return __hip_atomic_fetch_add(p, v, __ATOMIC_RELAXED, __HIP_MEMORY_SCOPE_AGENT); }
__device__ __forceinline__ unsigned xb_xcc_id() { return (unsigned)__builtin_amdgcn_s_getreg((3 << 11) | 20) & 0xFu; }
#define XB_SPIN(cond, bar) do { unsigned _sp = 0; while (cond) { __builtin_amdgcn_s_sleep(1); \
    if ((++_sp & 255u) == 0u) { if (xb_ld(&(bar)[XB_TMO])) break; if (_sp > XB_SPIN_CAP) { atomicAdd(&(bar)[XB_TMO], 1u); break; } } } } while (0)

struct XcdBarrier {
    unsigned* bar; unsigned x;
    volatile LAS unsigned* st;
};

__device__ __forceinline__ XcdBarrier xcd_barrier_post(unsigned* bar, volatile LAS unsigned* st) {
    XcdBarrier b; b.bar = bar; b.x = xb_xcc_id(); b.st = st;
    if (threadIdx.x == 0) (void)xb_add(&bar[XB_XCNT(b.x)], 1u);
    return b;
}
__device__ __forceinline__ void xcd_barrier_complete(unsigned* bar, unsigned x, unsigned& nloc, unsigned& nx) {
    const unsigned G = gridDim.x * gridDim.y * gridDim.z;
    unsigned sum, cnt, mine, sp = 0u;
    for (;;) {
        sum = 0u; cnt = 0u; mine = 0u;
#pragma unroll
        for (unsigned j = 0; j < 16; ++j) { const unsigned c = xb_ld(&bar[XB_XCNT(j)]); sum += c; cnt += (c > 0u) ? 1u : 0u; mine = (j == x) ? c : mine; }
        if (sum == G) break;
        __builtin_amdgcn_s_sleep(1);
        if ((++sp & 255u) == 0u) { if (xb_ld(&bar[XB_TMO])) break; if (sp > XB_SPIN_CAP) { atomicAdd(&bar[XB_TMO], 1u); break; } }
    }
    nloc = mine > 0u ? mine : 1u; nx = cnt > 0u ? cnt : 1u;
}

__device__ __forceinline__ void xcd_barrier(const XcdBarrier& b) {
    asm volatile("s_waitcnt vmcnt(0)" ::: "memory");
    __syncthreads();
    if (threadIdx.x == 0) {
        unsigned* bar = b.bar;
        __builtin_amdgcn_s_waitcnt(0);
        unsigned nloc = b.st[0], nx = b.st[1];
        if (nloc == 0u) { xcd_barrier_complete(bar, b.x, nloc, nx); b.st[0] = nloc; b.st[1] = nx; }
        const unsigned old = xb_add(&bar[XB_XSUB(b.x)], 1u);
        const unsigned gen = old / nloc;
        if (old + 1u == (gen + 1u) * nloc) {
            __builtin_amdgcn_fence(__ATOMIC_RELEASE, "agent");
            asm volatile("s_waitcnt vmcnt(0)" ::: "memory");
            const unsigned og = xb_add(&bar[XB_TOP], 1u);
            const unsigned tg = og / nx;
            if (og + 1u == (tg + 1u) * nx) xb_add(&bar[XB_TOPGEN], 1u);
            else XB_SPIN(xb_ld(&bar[XB_TOPGEN]) == tg, bar);
            __builtin_amdgcn_fence(__ATOMIC_ACQUIRE, "agent");
            xb_add(&bar[XB_XGEN(b.x)], 1u);
            asm volatile("s_waitcnt vmcnt(0)" ::: "memory");
        } else {
            XB_SPIN(xb_ld(&bar[XB_XGEN(b.x)]) == gen, bar);
            __builtin_amdgcn_fence(__ATOMIC_ACQUIRE, "agent");
            asm volatile("s_waitcnt vmcnt(0)" ::: "memory");
        }
    }
    __syncthreads();
}
constexpr int CW_QUEUE = 8192;
constexpr int MISC_OFF = 131072 + 320;
constexpr int LDS_BYTES = 147456;
#ifndef MK_N_LAUNCHES
#define MK_N_LAUNCHES 1
#endif
__global__ void __launch_bounds__(NTHR, 2) fwd_megakernel(Args a) {
    extern __shared__ __attribute__((aligned(16))) unsigned char lds_raw[];
    LAS unsigned char* lds = (LAS unsigned char*)lds_raw;
    const int tid = threadIdx.x, lane = tid & 63, wave = __builtin_amdgcn_readfirstlane(tid >> 6), G = gridDim.x;
    cg::grid_group grid = cg::this_grid();
    volatile LAS unsigned* MISC = (volatile LAS unsigned*)(lds + MISC_OFF);
    if (tid < 32) MISC[tid] = 0u;
    __syncthreads();
    XcdBarrier bar = xcd_barrier_post((unsigned*)(a.ws + WS_CTL), MISC + 8);
    unsigned char* ws = a.ws;
    const int lo = a.ph_lo, hi = a.ph_hi;
#define IN(k) (lo <= (k) && (k) < hi)
#ifdef PROBE_PHASE
    unsigned long long tsv[NPH + 1]; tsv[0] = __builtin_amdgcn_s_memrealtime();
#define SEAM(k) do { if (IN(k) && IN((k) + 1)) grid.sync(); tsv[(k) + 1] = __builtin_amdgcn_s_memrealtime(); } while (0)
#elif defined(PROBE_DUP_SYNC)
#define SEAM(k) do { if (IN(k) && IN((k) + 1)) { xcd_barrier(bar); xcd_barrier(bar); } } while (0)
#else
#define SEAM(k) do { if (IN(k) && IN((k) + 1)) xcd_barrier(bar); } while (0)
#endif
    if (hi > NPH) grid.sync();

    if (IN(0)) p0_prologue(a, lds, tid, lane, wave, G);
#ifdef PROBE_DUP_P0
    if (IN(0)) { __syncthreads(); p0_prologue(a, lds, tid, lane, wave, G); }
#endif
    SEAM(0);
    if (IN(1)) {
        pg8::Gemm g{(const pg8::bf16_t*)a.out, (const pg8::bf16_t*)(ws + WS_WIN), M, INC, 1024}; pg8::StaticOrder S; S.init(M, INC, G, (int)blockIdx.x);
        Epi1 E{ws};
        pg8::gemm_phase<Epi1, pg8::StaticOrder, true, true>(lds, g, S, E);
#ifdef PROBE_DUP_P1
        pg8::gemm_phase<Epi1, pg8::StaticOrder, true, true>(lds, g, S, E);
#endif
    }
    SEAM(1);
    if (IN(2)) {
#ifdef PROBE_DUP_RET
        for (int u = blockIdx.x; u < BATCH * RH; u += G) ret_unit(a, lds, u, tid, lane, wave, (bf16*)a.out);
#endif
        for (int u = blockIdx.x; u < BATCH * RH; u += G) ret_unit(a, lds, u, tid, lane, wave, (bf16*)(ws + WS_RG));
#ifdef PROBE_DUP_ATT
        { unsigned* qhead2 = (unsigned*)(ws + WS_CTL) + CW_QUEUE + 64;
        for (;;) {
            if (tid == 0) MISC[0] = __hip_atomic_fetch_add(qhead2, 1u, __ATOMIC_RELAXED, __HIP_MEMORY_SCOPE_AGENT);
            __syncthreads();
            const int u = (int)MISC[0];
            if (u >= BATCH * AKH * 16) break;
            attn_unit(a, lds, u, tid, lane, wave, (bf16*)a.out + (size_t)M * 1024);
        } __syncthreads(); }
#endif
        unsigned* qhead = (unsigned*)(ws + WS_CTL) + CW_QUEUE;
        for (;;) {
            if (tid == 0) MISC[0] = __hip_atomic_fetch_add(qhead, 1u, __ATOMIC_RELAXED, __HIP_MEMORY_SCOPE_AGENT);
            __syncthreads();
            const int u = (int)MISC[0];
            if (u >= BATCH * AKH * 16) break;
            attn_unit(a, lds, u, tid, lane, wave, (bf16*)(ws + WS_AQ));
        }
    }
    SEAM(2);
    if (IN(3)) {
        pg8::Gemm g{(const pg8::bf16_t*)(ws + WS_RG), (const pg8::bf16_t*)(ws + WS_WBR), 2 * M, 2048, 1024}; Sched3 S; S.S.init(M, 1024, G, (int)blockIdx.x);
        Epi3 E{(const bf16*)(ws + WS_GA), (const bf16*)(ws + WS_GB), (bf16*)(ws + WS_GB)};
        pg8::gemm_phase<Epi3, Sched3, true, true>(lds, g, S, E);
    }
    SEAM(3);
    if (IN(4)) {
        pg8::Gemm g{(const pg8::bf16_t*)(ws + WS_GB), (const pg8::bf16_t*)(ws + WS_WO), M, 1024, 1024}; pg8::StaticOrder S; S.init(M, 1024, G, (int)blockIdx.x);
        Epi4 E{a.in[0], (bf16*)(ws + WS_XB), (float*)(ws + WS_SSQ1)};
        pg8::gemm_phase<Epi4, pg8::StaticOrder, true, true>(lds, g, S, E);
    }
    SEAM(4);
    if (IN(5)) {
        pg8::Gemm g{(const pg8::bf16_t*)(ws + WS_XB), (const pg8::bf16_t*)(ws + WS_WGU), M, 2 * DFF, 1024}; pg8::StaticOrder S; S.init(M, 2 * DFF, G, (int)blockIdx.x);
        Epi5 E{(bf16*)(ws + WS_ACT), (const float*)(ws + WS_SSQ1)};
        pg8::gemm_phase<Epi5, pg8::StaticOrder, true, true>(lds, g, S, E);
#ifdef PROBE_DUP_P5
        pg8::gemm_phase<Epi5, pg8::StaticOrder, true, true>(lds, g, S, E);
#endif
    }
    SEAM(5);
    if (IN(6)) {
        pg8::Gemm g{(const pg8::bf16_t*)(ws + WS_ACT), (const pg8::bf16_t*)(ws + WS_WD), M, 1024, DFF}; pg8::StaticOrder S; S.init(M, 1024, G, (int)blockIdx.x);
        Epi6 E{(const bf16*)(ws + WS_XB), a.out, (float*)(ws + WS_SSQ2)};
        pg8::gemm_phase<Epi6, pg8::StaticOrder, true, true>(lds, g, S, E);
    }
    SEAM(6);
    if (IN(7)) {
        const int gw = blockIdx.x * NWAVES + wave, NGW = G * NWAVES;
        const f32x4* gp = (const f32x4*)a.in[14] + lane; f32x4 g[4];
#pragma unroll
        for (int j = 0; j < 4; ++j) g[j] = gp[64 * j];
        const float* ssq = (const float*)(ws + WS_SSQ2);
#ifdef PROBE_DUP_P7
        for (int pass = 0; pass < 2; ++pass) {
        float* dstb = pass == 0 ? (float*)(ws + WS_GA) : a.out;
#else
        { float* dstb = a.out;
#endif
        for (int m = gw; m < M; m += NGW) {
            const f32x4* sp = (const f32x4*)(ssq + (size_t)m * 16); const f32x4 s0 = sp[0], s1 = sp[1], s2 = sp[2], s3 = sp[3];
            const float tot = ((s0[0] + s0[1]) + (s0[2] + s0[3])) + ((s1[0] + s1[1]) + (s1[2] + s1[3])) + ((s2[0] + s2[1]) + (s2[2] + s2[3])) + ((s3[0] + s3[1]) + (s3[2] + s3[3]));
            const float rstd = 1.0f / sqrtf(tot * (1.0f / DM) + RMS_EPS);
            const f32x4* xr = (const f32x4*)(a.out + (size_t)m * DM) + lane; f32x4* xw = (f32x4*)(dstb + (size_t)m * DM) + lane;
#pragma unroll
            for (int j = 0; j < 4; ++j) { f32x4 v = xr[64 * j]; v.x *= rstd * g[j].x; v.y *= rstd * g[j].y; v.z *= rstd * g[j].z; v.w *= rstd * g[j].w; xw[64 * j] = v; }
        }
        }
    }
#ifdef PROBE_PHASE
    tsv[NPH] = __builtin_amdgcn_s_memrealtime();
    if (blockIdx.x == 0 && tid == 0) { asm volatile("s_waitcnt vmcnt(0)" ::: "memory"); a.out[0] = (float)(tsv[PROBE_PHASE + 1] - tsv[PROBE_PHASE]) * 0.01f; }
#endif
#undef IN
#undef SEAM
}

extern "C" void kernel_launch(void* const* d_in, const int* in_sizes, int n_in, void* d_out, int out_size, void* d_ws, size_t ws_size, hipStream_t stream) {
    static int grid = 0;
    if (grid == 0) {
        if (n_in != 15 || out_size != M * DM || ws_size < (size_t)496 * MiB) { fprintf(stderr, "kernel_launch: unexpected shapes: n_in %d out %d ws %zu\n", n_in, out_size, ws_size); grid = -1; return; }
        int dev = 0, cus = 0, per_cu = 0;
        (void)hipGetDevice(&dev); (void)hipDeviceGetAttribute(&cus, hipDeviceAttributeMultiprocessorCount, dev);
        if (hipFuncSetAttribute((const void*)fwd_megakernel, hipFuncAttributeMaxDynamicSharedMemorySize, LDS_BYTES) != hipSuccess) { fprintf(stderr, "kernel_launch: hipFuncSetAttribute failed\n"); grid = -1; return; }
        if (hipOccupancyMaxActiveBlocksPerMultiprocessor(&per_cu, (const void*)fwd_megakernel, NTHR, LDS_BYTES) != hipSuccess || per_cu < 1) { fprintf(stderr, "kernel_launch: occupancy query says %d\n", per_cu); per_cu = 1; }
        (void)hipGetLastError();
        grid = cus * 1;
        if (grid <= 0) grid = 256;
    }
    if (grid < 0) return;
    (void)hipMemsetAsync((char*)d_ws + WS_CTL, 0, CTL_ZERO_BYTES, stream);
    Args a{};
    for (int i = 0; i < 15; ++i) a.in[i] = (const float*)d_in[i];
    a.out = (float*)d_out; a.ws = (unsigned char*)d_ws;
#if MK_N_LAUNCHES == 1
    a.ph_lo = 0; a.ph_hi = NPH;
    void* kargs[] = {&a};
    hipError_t e = hipLaunchCooperativeKernel((const void*)fwd_megakernel, dim3(grid), dim3(NTHR), kargs, LDS_BYTES, stream);
    if (e != hipSuccess) fprintf(stderr, "cooperative launch failed: %s (grid %d)\n", hipGetErrorString(e), grid);
#else
    for (int p = 0; p < NPH; ++p) { a.ph_lo = p; a.ph_hi = p + 1; hipLaunchKernelGGL(fwd_megakernel, dim3(grid), dim3(NTHR), LDS_BYTES, stream, a); }
#endif
}
```
